# Optimizing an MI355X kernel written in HIP

```python
import jax, jax.numpy as jnp
from jax import lax
import numpy as np

D_MODEL = 1024
BATCH = 4
SEQ = 8192
DEPTH = 1
DEC_BATCH = 128
DEC_SEQ = 1
PAST_LEN = 16384
PAGE_SIZE = 128

HEAD_DIM = 64
N_Q_HEADS = 8
N_KV_HEADS = 2
GQA_GROUP = N_Q_HEADS // N_KV_HEADS
ATTN_WIDTH = N_Q_HEADS * HEAD_DIM
KV_WIDTH = N_KV_HEADS * HEAD_DIM
WINDOW = 128
ROT_DIM = HEAD_DIM // 4
ROPE_THETA = 500000.0
N_REC_HEADS = 4
REC_DK = 128
REC_DV = 128
REC_WIDTH = N_REC_HEADS * REC_DK
REC_VWIDTH = N_REC_HEADS * REC_DV
REC_CHUNK = 64
MIX_WIDTH = ATTN_WIDTH + REC_VWIDTH
IN_SIZES = (ATTN_WIDTH, KV_WIDTH, KV_WIDTH, REC_WIDTH, REC_WIDTH, REC_VWIDTH, REC_VWIDTH)
IN_WIDTH = sum(IN_SIZES)
SPLIT_POINTS = tuple(int(s) for s in np.cumsum(IN_SIZES)[:-1])
D_FF = -(-8 * D_MODEL // (3 * 256)) * 256
EPS = 1e-6

kernel_name = 'hymba_swa_sink_hgrn2_decode_step'

F32 = jnp.float32


def _rmsnorm(x, g):
    xf = x.astype(F32)
    y = xf * lax.rsqrt(jnp.mean(xf * xf, axis=-1, keepdims=True) + EPS)
    return (y * g.astype(F32)).astype(x.dtype)


def _rope(x, pos):
    half = ROT_DIM // 2
    inv_freq = jnp.exp(-jnp.log(jnp.asarray(ROPE_THETA, F32)) * jnp.arange(half, dtype=F32) * (2.0 / ROT_DIM))
    ang = pos[:, None] * inv_freq[None, :]
    cos = jnp.cos(ang)[None, :, None, :]
    sin = jnp.sin(ang)[None, :, None, :]
    x1 = x[..., :half]
    x2 = x[..., half:ROT_DIM]
    return jnp.concatenate([x1 * cos - x2 * sin, x2 * cos + x1 * sin, x[..., ROT_DIM:]], axis=-1)


def _sink_probs(s, sink):
    m = jnp.maximum(jnp.max(s, axis=-1, keepdims=True), sink)
    p = jnp.exp(s - m)
    return p / (jnp.sum(p, axis=-1, keepdims=True) + jnp.exp(sink - m))


def _swa_prompt(q, k, v, sinks):
    B, T = q.shape[:2]
    nb = -(-T // WINDOW)
    pad = nb * WINDOW - T
    if pad:
        cfg = ((0, 0), (0, pad), (0, 0), (0, 0))
        q, k, v = jnp.pad(q, cfg), jnp.pad(k, cfg), jnp.pad(v, cfg)
    qb = q.reshape(B, nb, WINDOW, N_KV_HEADS, GQA_GROUP, HEAD_DIM)
    kb = k.reshape(B, nb, WINDOW, N_KV_HEADS, HEAD_DIM)
    vb = v.reshape(B, nb, WINDOW, N_KV_HEADS, HEAD_DIM)
    kk = jnp.concatenate([jnp.concatenate([jnp.zeros_like(kb[:, :1]), kb[:, :-1]], axis=1), kb], axis=2)
    vv = jnp.concatenate([jnp.concatenate([jnp.zeros_like(vb[:, :1]), vb[:, :-1]], axis=1), vb], axis=2)
    s = jnp.einsum('bnqhgd,bnkhd->bnhgqk', qb, kk) * (HEAD_DIM ** -0.5)
    qi = WINDOW + jnp.arange(WINDOW)
    ki = jnp.arange(2 * WINDOW)
    band = (ki[None, :] <= qi[:, None]) & (qi[:, None] - ki[None, :] < WINDOW)
    no_prev = (jnp.arange(nb)[:, None, None] == 0) & (ki < WINDOW)[None, None, :]
    valid = band[None] & ~no_prev
    s = jnp.where(valid[None, :, None, None], s, -jnp.inf)
    p = _sink_probs(s, sinks.reshape(1, 1, N_KV_HEADS, GQA_GROUP, 1, 1))
    o = jnp.einsum('bnhgqk,bnkhd->bnqhgd', p, vv)
    return o.reshape(B, nb * WINDOW, ATTN_WIDTH)[:, :T]


def _swa_sample(q, k, v, k_buf, v_buf, sinks, pos0):
    B, T = q.shape[:2]
    w_keep = k_buf.shape[1]
    kk = jnp.concatenate([k_buf.astype(F32), k], axis=1)
    vv = jnp.concatenate([v_buf.astype(F32), v], axis=1)
    qpos = pos0 + jnp.arange(T)
    kpos = pos0 - w_keep + jnp.arange(w_keep + T)
    valid = (kpos[None, :] <= qpos[:, None]) & (qpos[:, None] - kpos[None, :] < WINDOW)
    qg = q.reshape(B, T, N_KV_HEADS, GQA_GROUP, HEAD_DIM)
    s = jnp.einsum('bqhgd,bkhd->bhgqk', qg, kk) * (HEAD_DIM ** -0.5)
    s = jnp.where(valid[None, None, None], s, -jnp.inf)
    p = _sink_probs(s, sinks.reshape(1, N_KV_HEADS, GQA_GROUP, 1, 1))
    o = jnp.einsum('bhgqk,bkhd->bqhgd', p, vv).reshape(B, T, ATTN_WIDTH)
    return o, kk[:, -w_keep:], vv[:, -w_keep:]


def _hgrn2_scan(q, log_f, k, i, S0):
    B, T = q.shape[:2]
    C = min(REC_CHUNK, T)
    nc = -(-T // C)
    pad = nc * C - T
    if pad:
        cfg = ((0, 0), (0, pad), (0, 0), (0, 0))
        q, log_f, k, i = jnp.pad(q, cfg), jnp.pad(log_f, cfg), jnp.pad(k, cfg), jnp.pad(i, cfg)

    def to_chunks(a):
        return a.reshape(B, nc, C, *a.shape[2:]).swapaxes(0, 1)

    tri = jnp.tril(jnp.ones((C, C), dtype=bool))[None, :, :, None, None]

    def step(S, inp):
        qc, lc, kc, ic = inp
        b = jnp.cumsum(lc, axis=1)
        inter = jnp.einsum('bthk,bhkv->bthv', qc * jnp.exp(b), S)
        decay = jnp.exp(jnp.where(tri, b[:, :, None] - b[:, None, :], -jnp.inf))
        scores = jnp.einsum('btshk,bthk,bshk->btsh', decay, qc, kc)
        intra = jnp.einsum('btsh,bshv->bthv', scores, ic)
        b_last = b[:, -1]
        S_new = jnp.exp(b_last)[..., None] * S + jnp.einsum('bshk,bshv->bhkv', kc * jnp.exp(b_last[:, None] - b), ic)
        return S_new, inter + intra

    S_fin, o = lax.scan(step, S0, (to_chunks(q), to_chunks(log_f), to_chunks(k), to_chunks(i)))
    o = o.swapaxes(0, 1).reshape(B, nc * C, N_REC_HEADS, REC_DV)[:, :T]
    return o, S_fin


def _layer(x, pos0, w_in, w_out, w_gate, w_up, w_down, g_pre_mix, g_post_mix, g_pre_ffn, g_post_ffn,
           sinks, lb, rec_norm, k_buf, v_buf, S0):
    B, T, _ = x.shape
    h = _rmsnorm(x, g_pre_mix)
    aq, ak, av, rq, rf, ri, rg = jnp.split(h @ w_in, SPLIT_POINTS, axis=-1)
    pos = pos0 + jnp.arange(T, dtype=F32)
    q = _rope(aq.astype(F32).reshape(B, T, N_Q_HEADS, HEAD_DIM), pos)
    k = _rope(ak.astype(F32).reshape(B, T, N_KV_HEADS, HEAD_DIM), pos)
    v = av.astype(F32).reshape(B, T, N_KV_HEADS, HEAD_DIM)
    sinks = sinks.astype(F32)
    if k_buf is None:
        a = _swa_prompt(q, k, v, sinks)
        keep = min(WINDOW, T)
        k_new, v_new = k[:, -keep:], v[:, -keep:]
    else:
        a, k_new, v_new = _swa_sample(q, k, v, k_buf, v_buf, sinks, pos0)
    f = lb + (1.0 - lb) * jax.nn.sigmoid(rf.astype(F32))
    log_f = jnp.log(f).reshape(B, T, N_REC_HEADS, REC_DK)
    kr = (1.0 - f).reshape(B, T, N_REC_HEADS, REC_DK)
    qr = jax.nn.silu(rq.astype(F32)).reshape(B, T, N_REC_HEADS, REC_DK)
    ir = ri.astype(F32).reshape(B, T, N_REC_HEADS, REC_DV)
    o, S_new = _hgrn2_scan(qr, log_f, kr, ir, S0)
    o = o * lax.rsqrt(jnp.mean(o * o, axis=-1, keepdims=True) + EPS) * rec_norm.astype(F32)
    o = o.reshape(B, T, REC_VWIDTH) * jax.nn.silu(rg.astype(F32))
    mix = jnp.concatenate([a, o], axis=-1).astype(x.dtype) @ w_out
    x = x + _rmsnorm(mix, g_post_mix)
    h2 = _rmsnorm(x, g_pre_ffn)
    ffn = (jax.nn.silu(h2 @ w_gate) * (h2 @ w_up)) @ w_down
    x = x + _rmsnorm(ffn, g_post_ffn)
    return x, k_new, v_new, S_new


def setup_inputs(seed: int = 0) -> dict:
    key = jax.random.key(seed)
    ks = jax.random.split(key, 20)
    w_keep = min(WINDOW, PAST_LEN)
    nrm = jax.random.normal
    return {
        'x_prompt': nrm(ks[0], (BATCH, SEQ, D_MODEL), F32),
        'x_sample': nrm(ks[1], (DEC_BATCH, DEC_SEQ, D_MODEL), F32),
        'cache_k_win': nrm(ks[2], (DEPTH, DEC_BATCH, w_keep, N_KV_HEADS, HEAD_DIM), F32),
        'cache_v_win': nrm(ks[3], (DEPTH, DEC_BATCH, w_keep, N_KV_HEADS, HEAD_DIM), F32),
        'state_hgrn': 0.5 * nrm(ks[4], (DEPTH, DEC_BATCH, N_REC_HEADS, REC_DK, REC_DV), F32),
        'w_in': nrm(ks[5], (DEPTH, D_MODEL, IN_WIDTH), F32) * D_MODEL ** -0.5,
        'w_out': nrm(ks[6], (DEPTH, MIX_WIDTH, D_MODEL), F32) * MIX_WIDTH ** -0.5,
        'w_gate': nrm(ks[7], (DEPTH, D_MODEL, D_FF), F32) * D_MODEL ** -0.5,
        'w_up': nrm(ks[8], (DEPTH, D_MODEL, D_FF), F32) * D_MODEL ** -0.5,
        'w_down': nrm(ks[9], (DEPTH, D_FF, D_MODEL), F32) * D_FF ** -0.5,
        'norm_pre_mix': 1.0 + 0.02 * nrm(ks[10], (DEPTH, D_MODEL), F32),
        'norm_post_mix': 1.0 + 0.02 * nrm(ks[11], (DEPTH, D_MODEL), F32),
        'norm_pre_ffn': 1.0 + 0.02 * nrm(ks[12], (DEPTH, D_MODEL), F32),
        'norm_post_ffn': 1.0 + 0.02 * nrm(ks[13], (DEPTH, D_MODEL), F32),
        'attn_sinks': nrm(ks[14], (DEPTH, N_Q_HEADS), F32),
        'rec_lb': 0.5 * nrm(ks[15], (DEPTH + 1, REC_WIDTH), F32),
        'rec_out_norm': 1.0 + 0.02 * nrm(ks[16], (DEPTH, N_REC_HEADS, REC_DV), F32),
    }


def reference(x_prompt, x_sample, cache_k_win, cache_v_win, state_hgrn, w_in, w_out, w_gate, w_up, w_down,
              norm_pre_mix, norm_post_mix, norm_pre_ffn, norm_post_ffn, attn_sinks, rec_lb, rec_out_norm):
    lbs = jnp.cumsum(jax.nn.softmax(rec_lb.astype(F32), axis=0), axis=0)
    yp, ys = x_prompt, x_sample
    kp_l, vp_l, sp_l, ks_l, vs_l, ss_l = [], [], [], [], [], []
    for l in range(DEPTH):
        shared = (w_in[l], w_out[l], w_gate[l], w_up[l], w_down[l], norm_pre_mix[l], norm_post_mix[l],
                  norm_pre_ffn[l], norm_post_ffn[l], attn_sinks[l], lbs[l], rec_out_norm[l])
        S0 = jnp.zeros((yp.shape[0], N_REC_HEADS, REC_DK, REC_DV), F32)
        yp, kp, vp, sp = _layer(yp, 0, *shared, None, None, S0)
        ys, kn, vn, sn = _layer(ys, PAST_LEN, *shared, cache_k_win[l], cache_v_win[l], state_hgrn[l].astype(F32))
        kp_l.append(kp.astype(cache_k_win.dtype)); vp_l.append(vp.astype(cache_v_win.dtype)); sp_l.append(sp.astype(state_hgrn.dtype))
        ks_l.append(kn.astype(cache_k_win.dtype)); vs_l.append(vn.astype(cache_v_win.dtype)); ss_l.append(sn.astype(state_hgrn.dtype))
    new_k_win_prompt = jnp.stack(kp_l)
    new_v_win_prompt = jnp.stack(vp_l)
    new_state_prompt = jnp.stack(sp_l)
    new_k_win_sample = jnp.stack(ks_l)
    new_v_win_sample = jnp.stack(vs_l)
    new_state_sample = jnp.stack(ss_l)
    return (yp, ys, new_k_win_prompt, new_v_win_prompt, new_state_prompt, new_k_win_sample, new_v_win_sample, new_state_sample)
```

```cpp
#include <hip/hip_runtime.h>
#include <hip/hip_cooperative_groups.h>
#include <cstdio>
namespace cg = cooperative_groups;

#define LAS __attribute__((address_space(3)))
typedef unsigned short bf16_t;
typedef short bf16x8 __attribute__((ext_vector_type(8)));
typedef short bf16x4 __attribute__((ext_vector_type(4)));
typedef float f32x4 __attribute__((ext_vector_type(4)));
typedef unsigned u32x4 __attribute__((ext_vector_type(4)));
typedef unsigned u32x2 __attribute__((ext_vector_type(2)));

#ifndef N_LAUNCH_MODE
#define N_LAUNCH_MODE 0
#endif

constexpr int DM = 1024, TP = 32768, SEQ = 8192, NS = 128, MP = TP + 256, INW = 2816, DFF = 2816;
constexpr float EPS = 1e-6f;
constexpr int NPHASE = 10;
#ifndef PROBE_DUP
#define PROBE_DUP -1
#endif
constexpr int LDS_BYTES = 131072 + 16;

constexpr size_t al(size_t x) { return (x + 255) & ~(size_t)255; }
constexpr size_t WS_XB = 0;
constexpr size_t WS_PROJ = WS_XB + al((size_t)MP * DM * 2);
constexpr size_t WS_MIX = WS_PROJ + al((size_t)MP * INW * 2);
constexpr size_t WS_MIXO = WS_MIX + al((size_t)MP * DM * 2);
constexpr size_t WS_WIN = WS_MIXO + al((size_t)MP * DM * 2);
constexpr size_t WS_WOUT = WS_WIN + al((size_t)INW * DM * 2);
constexpr size_t WS_WGU = WS_WOUT + al((size_t)DM * DM * 2);
constexpr size_t WS_WDN = WS_WGU + al((size_t)2 * DFF * DM * 2);
constexpr size_t WS_RSTD1 = WS_WDN + al((size_t)DM * DFF * 2);
constexpr size_t WS_RSTD3 = WS_RSTD1 + al((size_t)MP * 4);
constexpr size_t WS_SS2 = WS_RSTD3 + al((size_t)MP * 4);
constexpr size_t WS_SS4 = WS_SS2 + al((size_t)MP * 16 * 4);
constexpr size_t WS_ROPE = WS_SS4 + al((size_t)MP * 16 * 4);
constexpr size_t WS_LB = WS_ROPE + al((size_t)8193 * 8 * 8);
constexpr size_t WS_HU = WS_LB + al(512 * 4);
constexpr size_t WS_HD = WS_HU + al((size_t)16 * 32 * 16384 * 4);
constexpr size_t WS_S2 = WS_HD + al((size_t)16 * 32 * 128 * 4);
constexpr size_t WS_S4 = WS_S2 + al((size_t)4 * NS * DM * 4);
constexpr size_t WS_S3 = WS_S4 + al((size_t)11 * NS * DM * 4);
constexpr size_t WS_BAR = WS_S3 + al((size_t)4 * NS * 2 * DFF * 4);
constexpr size_t WS_END = WS_BAR + al((size_t)3456 * 4);

constexpr size_t OUT_YP = 0;
constexpr size_t OUT_YS = OUT_YP + (size_t)TP * DM;
constexpr size_t OUT_KP = OUT_YS + (size_t)NS * DM;
constexpr size_t OUT_VP = OUT_KP + 65536;
constexpr size_t OUT_SP = OUT_VP + 65536;
constexpr size_t OUT_KS = OUT_SP + 262144;
constexpr size_t OUT_VS = OUT_KS + 2097152;
constexpr size_t OUT_SS = OUT_VS + 2097152;

struct Params {
    const float *xp, *xs, *ck, *cv, *st, *w_in, *w_out, *w_gate, *w_up, *w_down, *g1, *g2, *g3, *g4, *sinks, *rec_lb, *rec_norm;
    float* out; unsigned char* ws;
};

__device__ __forceinline__ float bf2f(bf16_t b) { return __uint_as_float(((unsigned)b) << 16); }
typedef float f32x2 __attribute__((ext_vector_type(2)));
typedef __bf16 bf16x2_t __attribute__((ext_vector_type(2)));
__device__ __forceinline__ bf16_t f2bf(float f) { const __bf16 b = (__bf16)f; bf16_t r; __builtin_memcpy(&r, &b, 2); return r; }
__device__ __forceinline__ unsigned cvt_pk_bf16(float lo, float hi) { const f32x2 v = {lo, hi}; const bf16x2_t b = __builtin_convertvector(v, bf16x2_t); unsigned r; __builtin_memcpy(&r, &b, 4); return r; }
__device__ __forceinline__ float lo_bf(unsigned u) { return __uint_as_float(u << 16); }
__device__ __forceinline__ float hi_bf(unsigned u) { return __uint_as_float(u & 0xFFFF0000u); }
__device__ __forceinline__ float silu_f(float x) { return x * __builtin_amdgcn_rcpf(1.0f + __expf(-x)); }
template <int CTRL> __device__ __forceinline__ float dpp_f(float v) {
    return __int_as_float(__builtin_amdgcn_update_dpp(0, __float_as_int(v), CTRL, 0xF, 0xF, true));
}
__device__ __forceinline__ float lane_f(float v, int l) { return __int_as_float(__builtin_amdgcn_readlane(__float_as_int(v), l)); }
__device__ __forceinline__ float wave_sum(float v) {
    v += dpp_f<0xB1>(v);
    v += dpp_f<0x4E>(v);
    v += dpp_f<0x141>(v);
    v += dpp_f<0x140>(v);
    return (lane_f(v, 0) + lane_f(v, 16)) + (lane_f(v, 32) + lane_f(v, 48));
}
__device__ __forceinline__ float wave_max(float v) {
    v = fmaxf(v, dpp_f<0xB1>(v));
    v = fmaxf(v, dpp_f<0x4E>(v));
    v = fmaxf(v, dpp_f<0x141>(v));
    v = fmaxf(v, dpp_f<0x140>(v));
    return fmaxf(fmaxf(lane_f(v, 0), lane_f(v, 16)), fmaxf(lane_f(v, 32), lane_f(v, 48)));
}
__device__ __forceinline__ void swap16(float x, float& a, float& b) { const auto r = __builtin_amdgcn_permlane16_swap(__float_as_uint(x), __float_as_uint(x), false, false); a = __uint_as_float(r[0]); b = __uint_as_float(r[1]); }
__device__ __forceinline__ void swap32(float x, float& a, float& b) { const auto r = __builtin_amdgcn_permlane32_swap(__float_as_uint(x), __float_as_uint(x), false, false); a = __uint_as_float(r[0]); b = __uint_as_float(r[1]); }
__device__ __forceinline__ float xsum_rows(float x) { float a, b; swap16(x, a, b); x = a + b; swap32(x, a, b); return a + b; }
__device__ __forceinline__ float xmax_rows(float x) { float a, b; swap16(x, a, b); x = fmaxf(a, b); swap32(x, a, b); return fmaxf(a, b); }
#define MFMA16(a, b, c) __builtin_amdgcn_mfma_f32_16x16x32_bf16(a, b, c, 0, 0, 0)


#define XB_TMO      128
#define XB_XCNT(j)  (256  + 64 * (j))
#define XB_XSUB(j)  (1280 + 64 * (j))
#define XB_XGEN(j)  (2304 + 64 * (j))
#define XB_TOP      3328
#define XB_TOPGEN   3392
#define XCD_BAR_WORDS 3456
#define XB_SPIN_CAP (1u << 18)
__device__ __forceinline__ unsigned xb_ld(unsigned* p)              { return __hip_atomic_load(p, __ATOMIC_RELAXED, __HIP_MEMORY_SCOPE_AGENT); }
__device__ __forceinline__ unsigned xb_add(unsigned* p, unsigned v) { return __hip_atomic_fetch_add(p, v, __ATOMIC_RELAXED, __HIP_MEMORY_SCOPE_AGENT); }
__device__ __forceinline__ unsigned xb_xcc_id() { return (unsigned)__builtin_amdgcn_s_getreg((3 << 11) | 20) & 0xFu; }
#define XB_SPIN(cond, bar) do { unsigned _sp = 0; while (cond) { __builtin_amdgcn_s_sleep(1); \
    if ((++_sp & 255u) == 0u) { if (xb_ld(&(bar)[XB_TMO])) break; if (_sp > XB_SPIN_CAP) { atomicAdd(&(bar)[XB_TMO], 1u); break; } } } } while (0)
struct XcdBarrier { unsigned* bar; unsigned x; volatile LAS unsigned* st; };
__device__ __forceinline__ XcdBarrier xcd_barrier_post(unsigned* bar, volatile LAS unsigned* st) {
    XcdBarrier b; b.bar = bar; b.x = xb_xcc_id(); b.st = st;
    if (threadIdx.x == 0) (void)xb_add(&bar[XB_XCNT(b.x)], 1u);
    return b;
}
__device__ __forceinline__ void xcd_barrier_complete(unsigned* bar, unsigned x, unsigned& nloc, unsigned& nx) {
    const unsigned G = gridDim.x * gridDim.y * gridDim.z;
    unsigned sum, cnt, mine, sp = 0u;
    for (;;) {
        sum = 0u; cnt = 0u; mine = 0u;
#pragma unroll
        for (unsigned j = 0; j < 16; ++j) { const unsigned c = xb_ld(&bar[XB_XCNT(j)]); sum += c; cnt += (c > 0u) ? 1u : 0u; mine = (j == x) ? c : mine; }
        if (sum == G) break;
        __builtin_amdgcn_s_sleep(1);
        if ((++sp & 255u) == 0u) { if (xb_ld(&bar[XB_TMO])) break; if (sp > XB_SPIN_CAP) { atomicAdd(&bar[XB_TMO], 1u); break; } }
    }
    nloc = mine > 0u ? mine : 1u; nx = cnt > 0u ? cnt : 1u;
}
__device__ __forceinline__ void xcd_barrier(unsigned* bar_, volatile LAS unsigned* st_) {
    XcdBarrier b; b.bar = bar_; b.x = xb_xcc_id(); b.st = st_;
    asm volatile("s_waitcnt vmcnt(0)" ::: "memory");
    __syncthreads();
    if (threadIdx.x == 0) {
        unsigned* bar = b.bar;
        __builtin_amdgcn_s_waitcnt(0);
        unsigned nloc = b.st[0], nx = b.st[1];
        if (nloc == 0u) { xcd_barrier_complete(bar, b.x, nloc, nx); b.st[0] = nloc; b.st[1] = nx; }
        const unsigned old = xb_add(&bar[XB_XSUB(b.x)], 1u);
        const unsigned gen = old / nloc;
        if (old + 1u == (gen + 1u) * nloc) {
            __builtin_amdgcn_fence(__ATOMIC_RELEASE, "agent");
            asm volatile("s_waitcnt vmcnt(0)" ::: "memory");
            const unsigned og = xb_add(&bar[XB_TOP], 1u);
            const unsigned tg = og / nx;
            if (og + 1u == (tg + 1u) * nx) xb_add(&bar[XB_TOPGEN], 1u);
            else XB_SPIN(xb_ld(&bar[XB_TOPGEN]) == tg, bar);
            __builtin_amdgcn_fence(__ATOMIC_ACQUIRE, "agent");
            xb_add(&bar[XB_XGEN(b.x)], 1u);
            asm volatile("s_waitcnt vmcnt(0)" ::: "memory");
        } else {
            XB_SPIN(xb_ld(&bar[XB_XGEN(b.x)]) == gen, bar);
            __builtin_amdgcn_fence(__ATOMIC_ACQUIRE, "agent");
            asm volatile("s_waitcnt vmcnt(0)" ::: "memory");
        }
    }
    __syncthreads();
}

namespace pg8 {
constexpr int BM = 256, BK = 64, HALF = 128, HTB = HALF * BK * 2, NXCD = 8, WGM = 8;
__device__ __forceinline__ int lds_byte(int r, int c) { const int st = (r >> 4) * 2 + (c >> 5), rr = r & 15, cc = c & 31, ob = rr * 64 + cc * 2; return st * 1024 + (ob ^ (((ob >> 9) & 1) << 5)); }
__device__ __forceinline__ void stage_rc(int b, int& R, int& C) { const int st = b / 1024, sb = b % 1024, swz = sb ^ (((sb >> 9) & 1) << 5); R = (st >> 1) * 16 + swz / 64; C = (st & 1) * 32 + (swz % 64) / 2; }
__device__ __forceinline__ int perm32(int rho) { const int n = rho >> 4, i = rho & 15; return 8 * (i >> 2) + 4 * n + (i & 3); }
struct Unit { int pm, pn, koff, nt, mini; };
struct Gemm { const bf16_t* A; const bf16_t* Bt; int M, N, K; };
struct StaticOrder {
    int nM, nN, nwg, G, c, ntm, nextra;
    __device__ void init(int M, int N, int K, int G_, int c_, int nextra_) { nM = M / BM; nN = N / BM; nwg = nM * nN; G = G_; c = c_; ntm = K / BK; nextra = nextra_; }
    __device__ bool next(int i, Unit& u) const {
        const long L = (long)i * G + c;
        if (L >= nwg) {
            const long e = L - nwg; if (e >= nextra) return false;
            u.pm = nM; u.pn = (int)(e % nN); u.koff = (int)(e / nN) * 512; u.nt = 4; u.mini = 1; return true;
        }
        int wgid = (int)L; { const int q = nwg / NXCD, r = nwg % NXCD, xcd = wgid % NXCD, off = wgid / NXCD; wgid = (xcd < r ? xcd * (q + 1) : r * (q + 1) + (xcd - r) * q) + off; }
        const int nig = WGM * nN, gid = wgid / nig, fm = gid * WGM, gsz = (nM - fm) < WGM ? (nM - fm) : WGM;
        u.pm = fm + ((wgid % nig) % gsz); u.pn = (wgid % nig) / gsz; u.koff = 0; u.nt = ntm; u.mini = 0; return true;
    }
};

template <class Epi>
__device__ __forceinline__ void gemm_phase(LAS unsigned char* lds, const Gemm g, const StaticOrder& S, const Epi& E) {
    const int tid = threadIdx.x, wid = __builtin_amdgcn_readfirstlane(tid >> 6), lane = tid & 63, wr = wid >> 2, wc = wid & 3, fr = lane & 15, fq = lane >> 4;
    const int K = g.K;
    unsigned voffA[2], voffB[2];
#pragma unroll
    for (int i = 0; i < 2; ++i) { int R, C; stage_rc(tid * 16 + i * 8192, R, C); const int Rb = (R & ~31) + perm32(R & 31);
        voffA[i] = (unsigned)(R * K + C) * 2u; voffB[i] = (unsigned)(Rb * K + C) * 2u; }
    const size_t kstep = (size_t)(BK * 2);
    const size_t hstep = (size_t)HALF * K * 2;
    const size_t tstep = 2 * hstep;
    const unsigned ldsw = (unsigned)wid * 1024u;
    const int aoff = lds_byte(wr * 64 + fr, fq * 8), boff = lds_byte(wc * 32 + fr, fq * 8);
#define PG8_SA(b, h) (((b) * 2 + (h)) * HTB)
#define PG8_SB(b, h) ((4 + (b) * 2 + (h)) * HTB)
#define PG8_STAGE(bufoff, gbase, voff) do { _Pragma("unroll") for (int _i = 0; _i < 2; ++_i) \
        __builtin_amdgcn_global_load_lds((const unsigned*)((const char*)(gbase) + (voff)[_i]), (LAS unsigned*)(lds + (bufoff) + ldsw + _i * 8192), 16, 0, 0); } while (0)
#define PG8_LDA(dst, b, h) do { _Pragma("unroll") for (int m = 0; m < 4; ++m) _Pragma("unroll") for (int k = 0; k < 2; ++k) dst[m][k] = *(const LAS bf16x8*)(lds + PG8_SA(b, h) + aoff + m * 2048 + k * 1024); } while (0)
#define PG8_LDB(dst, b, h) do { _Pragma("unroll") for (int n = 0; n < 2; ++n) _Pragma("unroll") for (int k = 0; k < 2; ++k) dst[n][k] = *(const LAS bf16x8*)(lds + PG8_SB(b, h) + boff + n * 2048 + k * 1024); } while (0)
#define PG8_MMA(ai, bj, At, Bt) do { __builtin_amdgcn_s_setprio(1); _Pragma("unroll") for (int m = 0; m < 4; ++m) _Pragma("unroll") for (int n = 0; n < 2; ++n) _Pragma("unroll") for (int k = 0; k < 2; ++k) \
        acc[ai][bj][m][n] = __builtin_amdgcn_mfma_f32_16x16x32_bf16(Bt[n][k], At[m][k], acc[ai][bj][m][n], 0, 0, 0); __builtin_amdgcn_s_setprio(0); } while (0)
#define PG8_WAIT_V(n) asm volatile("s_waitcnt vmcnt(" #n ")" ::: "memory")
#define PG8_WAIT_L(n) asm volatile("s_waitcnt lgkmcnt(" #n ")" ::: "memory")
#define PG8_BAR __builtin_amdgcn_s_barrier()
#define PG8_SCHED __builtin_amdgcn_sched_barrier(0)
    Unit cur, nxt; int ui = 0;
    if (!S.next(0, cur)) return;
    f32x4 acc[2][2][4][2];
#pragma unroll
    for (int a = 0; a < 2; ++a)
#pragma unroll
        for (int b = 0; b < 2; ++b)
#pragma unroll
            for (int m = 0; m < 4; ++m)
#pragma unroll
                for (int n = 0; n < 2; ++n) acc[a][b][m][n] = (f32x4){0.f, 0.f, 0.f, 0.f};
    bf16x8 At[4][2], B0[2][2], B1[2][2];
    const char* cA = (const char*)g.A + (size_t)cur.pm * tstep + cur.koff; const char* cB = (const char*)g.Bt + (size_t)cur.pn * tstep + cur.koff;
    PG8_STAGE(PG8_SB(0, 0), cB, voffB); PG8_STAGE(PG8_SA(0, 0), cA, voffA); PG8_STAGE(PG8_SB(0, 1), cB + hstep, voffB); PG8_STAGE(PG8_SA(0, 1), cA + hstep, voffA);
    if (wr == 1) PG8_BAR;
    PG8_WAIT_V(4); PG8_BAR;
    PG8_STAGE(PG8_SB(1, 0), cB + kstep, voffB); PG8_STAGE(PG8_SA(1, 0), cA + kstep, voffA); PG8_STAGE(PG8_SB(1, 1), cB + hstep + kstep, voffB);
    PG8_WAIT_V(6); PG8_BAR;
    for (;;) {
        const bool has_next = S.next(ui + 1, nxt);
        const char* nA = has_next ? (const char*)g.A + (size_t)nxt.pm * tstep + nxt.koff : cA; const char* nB = has_next ? (const char*)g.Bt + (size_t)nxt.pn * tstep + nxt.koff : cB;
        const int nt = cur.nt;
        for (int t = 0; t < nt; t += 2) {
            const bool last = (t == nt - 2);
            const char* a1 = cA + (size_t)(t + 1) * kstep;
            const char* a2 = last ? nA : cA + (size_t)(t + 2) * kstep; const char* b2 = last ? nB : cB + (size_t)(t + 2) * kstep;
            const char* a3 = a2 + kstep; const char* b3 = b2 + kstep;
            PG8_LDB(B0, 0, 0); PG8_SCHED; PG8_LDA(At, 0, 0); PG8_STAGE(PG8_SA(1, 1), a1 + hstep, voffA);
            PG8_WAIT_L(8); PG8_BAR; PG8_WAIT_L(0); PG8_MMA(0, 0, At, B0); PG8_BAR; PG8_SCHED;
            PG8_LDB(B1, 0, 1); PG8_STAGE(PG8_SB(0, 0), b2, voffB);
            PG8_BAR; PG8_WAIT_L(0); PG8_MMA(0, 1, At, B1); PG8_BAR;
            PG8_LDA(At, 0, 1); PG8_STAGE(PG8_SA(0, 0), a2, voffA);
            PG8_BAR; PG8_WAIT_L(0); PG8_MMA(1, 0, At, B0); PG8_BAR; PG8_SCHED;
            PG8_STAGE(PG8_SB(0, 1), b2 + hstep, voffB);
            PG8_WAIT_V(6); PG8_BAR; PG8_MMA(1, 1, At, B1); PG8_BAR;
            PG8_LDB(B0, 1, 0); PG8_SCHED; PG8_LDA(At, 1, 0); PG8_STAGE(PG8_SA(0, 1), a2 + hstep, voffA);
            PG8_WAIT_L(8); PG8_BAR; PG8_WAIT_L(0); PG8_MMA(0, 0, At, B0); PG8_BAR; PG8_SCHED;
            PG8_LDB(B1, 1, 1); PG8_STAGE(PG8_SB(1, 0), b3, voffB);
            PG8_BAR; PG8_WAIT_L(0); PG8_MMA(0, 1, At, B1); PG8_BAR;
            PG8_LDA(At, 1, 1); PG8_STAGE(PG8_SA(1, 0), a3, voffA);
            PG8_BAR; PG8_WAIT_L(0); PG8_MMA(1, 0, At, B0); PG8_BAR; PG8_SCHED;
            PG8_STAGE(PG8_SB(1, 1), b3 + hstep, voffB);
            PG8_WAIT_V(6); PG8_BAR; PG8_MMA(1, 1, At, B1); PG8_BAR;
        }
        E(acc, cur, wr, wc, fr, fq);
        if (!has_next) break;
#pragma unroll
        for (int a = 0; a < 2; ++a)
#pragma unroll
            for (int b = 0; b < 2; ++b)
#pragma unroll
                for (int m = 0; m < 4; ++m)
#pragma unroll
                    for (int n = 0; n < 2; ++n) acc[a][b][m][n] = (f32x4){0.f, 0.f, 0.f, 0.f};
        cur = nxt; cA = nA; cB = nB; ++ui;
    }
    PG8_WAIT_V(0);
    if (wr == 0) PG8_BAR;
    PG8_BAR;
#undef PG8_SA
#undef PG8_SB
#undef PG8_STAGE
#undef PG8_LDA
#undef PG8_LDB
#undef PG8_MMA
#undef PG8_WAIT_V
#undef PG8_WAIT_L
#undef PG8_BAR
#undef PG8_SCHED
}
}

struct EpiIn {
    bf16_t* proj; const float* rstd; const float* lb;
    __device__ __forceinline__ void operator()(const f32x4 (&acc)[2][2][4][2], const pg8::Unit& u, int wr, int wc, int fr, int fq) const {
        const int row0 = u.pm * 256 + wr * 64 + fr;
        const int cl = wc * 32 + 8 * fq;
        float rs[2][4];
#pragma unroll
        for (int ai = 0; ai < 2; ++ai)
#pragma unroll
            for (int m = 0; m < 4; ++m) rs[ai][m] = rstd[row0 + ai * 128 + m * 16];
        const bool is_rf = (u.pn == 5 || u.pn == 6);
        f32x4 lbv[2][2];
        if (is_rf) {
#pragma unroll
            for (int bj = 0; bj < 2; ++bj) { const float* lbp = lb + (u.pn * 2 + bj - 10) * 128 + cl; lbv[bj][0] = *(const f32x4*)lbp; lbv[bj][1] = *(const f32x4*)(lbp + 4); }
        }
#pragma unroll
        for (int bj = 0; bj < 2; ++bj) {
            const int hc = u.pn * 2 + bj;
#pragma unroll
            for (int ai = 0; ai < 2; ++ai)
#pragma unroll
                for (int m = 0; m < 4; ++m) {
                    const int row = row0 + ai * 128 + m * 16;
                    const float rsv = rs[ai][m];
                    float v[8];
#pragma unroll
                    for (int i = 0; i < 8; ++i) v[i] = acc[ai][bj][m][i >> 2][i & 3] * rsv;
                    if (hc < 5) {
                        if (hc < 4) {
#pragma unroll
                            for (int i = 0; i < 8; ++i) v[i] *= 0.18033688011112042f;
                        }
                        if ((wc & 1) == 0) {
                            const unsigned RFX[8] = {683565276u, 132558854u, 25706177u, 4985012u, 966707u, 187467u, 36354u, 7050u};
                            const unsigned pos = row < TP ? (unsigned)(row & (SEQ - 1)) : 16384u;
#pragma unroll
                            for (int i = 0; i < 8; ++i) {
                                float pa, pb; swap16(v[i], pa, pb);
                                const float o = (fq & 1) ? pa : pb;
                                const float rf_ = (float)(pos * RFX[i]) * 2.3283064365386963e-10f;
                                const float c = __builtin_amdgcn_cosf(rf_), sn = __builtin_amdgcn_sinf(rf_);
                                const float r0 = v[i] * c - o * sn, r1 = v[i] * c + o * sn;
                                v[i] = fq == 0 ? r0 : (fq == 1 ? r1 : v[i]);
                            }
                        }
                    } else if ((hc >= 6 && hc < 10) || hc >= 18) {
#pragma unroll
                        for (int i = 0; i < 8; ++i) v[i] = silu_f(v[i]);
                    } else if (hc >= 10 && hc < 14) {
#pragma unroll
                        for (int i = 0; i < 8; ++i) {
                            const float l = lbv[bj][i >> 2][i & 3];
                            const float sg = __builtin_amdgcn_rcpf(1.0f + __expf(-v[i]));
                            v[i] = __logf(l + (1.0f - l) * sg);
                        }
                    }
                    u32x4 w; w.x = cvt_pk_bf16(v[0], v[1]); w.y = cvt_pk_bf16(v[2], v[3]); w.z = cvt_pk_bf16(v[4], v[5]); w.w = cvt_pk_bf16(v[6], v[7]);
                    *(u32x4*)(proj + (size_t)row * INW + hc * 128 + cl) = w;
                }
        }
    }
};
struct EpiSq {
    bf16_t* O; float* ss; float* sb;
    __device__ __forceinline__ void operator()(const f32x4 (&acc)[2][2][4][2], const pg8::Unit& u, int wr, int wc, int fr, int fq) const {
        if (u.mini) {
            const int col0 = u.pn * 256 + wc * 32 + 8 * fq;
            float* slab = sb + (size_t)(u.koff >> 9) * (NS * DM);
#pragma unroll
            for (int m = 0; m < 4; ++m) {
                float* rp = slab + (size_t)(wr * 64 + m * 16 + fr) * DM + col0;
#pragma unroll
                for (int bj = 0; bj < 2; ++bj) { *(f32x4*)(rp + bj * 128) = acc[0][bj][m][0]; *(f32x4*)(rp + bj * 128 + 4) = acc[0][bj][m][1]; }
            }
            return;
        }
        const int row0 = u.pm * 256 + wr * 64 + fr;
        const int col0 = u.pn * 256 + wc * 32 + 8 * fq;
#pragma unroll
        for (int ai = 0; ai < 2; ++ai)
#pragma unroll
            for (int m = 0; m < 4; ++m) {
                const int row = row0 + ai * 128 + m * 16;
                float s = 0.f;
#pragma unroll
                for (int bj = 0; bj < 2; ++bj) {
                    const f32x4 v0 = acc[ai][bj][m][0], v1 = acc[ai][bj][m][1];
                    s += v0[0] * v0[0] + v0[1] * v0[1] + v0[2] * v0[2] + v0[3] * v0[3] + v1[0] * v1[0] + v1[1] * v1[1] + v1[2] * v1[2] + v1[3] * v1[3];
                    u32x4 w; w.x = cvt_pk_bf16(v0[0], v0[1]); w.y = cvt_pk_bf16(v0[2], v0[3]); w.z = cvt_pk_bf16(v1[0], v1[1]); w.w = cvt_pk_bf16(v1[2], v1[3]);
                    *(u32x4*)(O + (size_t)row * DM + col0 + bj * 128) = w;
                }
                s = xsum_rows(s);
                if (fq == 0) ss[(size_t)row * 16 + u.pn * 4 + wc] = s;
            }
    }
};
struct EpiGU {
    bf16_t* act; const float* rstd; float* sb;
    __device__ __forceinline__ void operator()(const f32x4 (&acc)[2][2][4][2], const pg8::Unit& u, int wr, int wc, int fr, int fq) const {
        if (u.mini) {
            const int colt = u.pn * 256 + wc * 32 + 8 * fq;
            float* slab = sb + (size_t)(u.koff >> 9) * (NS * 2 * DFF);
#pragma unroll
            for (int m = 0; m < 4; ++m) {
                float* rp = slab + (size_t)(wr * 64 + m * 16 + fr) * (2 * DFF) + colt;
#pragma unroll
                for (int bj = 0; bj < 2; ++bj) { *(f32x4*)(rp + bj * 128) = acc[0][bj][m][0]; *(f32x4*)(rp + bj * 128 + 4) = acc[0][bj][m][1]; }
            }
            return;
        }
        const int row0 = u.pm * 256 + wr * 64 + fr;
        const int col0 = u.pn * 128 + wc * 32 + 8 * fq;
        float rs[2][4];
#pragma unroll
        for (int ai = 0; ai < 2; ++ai)
#pragma unroll
            for (int m = 0; m < 4; ++m) rs[ai][m] = rstd[row0 + ai * 128 + m * 16];
#pragma unroll
        for (int ai = 0; ai < 2; ++ai)
#pragma unroll
            for (int m = 0; m < 4; ++m) {
                const int row = row0 + ai * 128 + m * 16;
                const float rsv = rs[ai][m];
                float a[8];
#pragma unroll
                for (int i = 0; i < 8; ++i) { const float gv = acc[ai][0][m][i >> 2][i & 3] * rsv, uv = acc[ai][1][m][i >> 2][i & 3] * rsv; a[i] = silu_f(gv) * uv; }
                u32x4 w; w.x = cvt_pk_bf16(a[0], a[1]); w.y = cvt_pk_bf16(a[2], a[3]); w.z = cvt_pk_bf16(a[4], a[5]); w.w = cvt_pk_bf16(a[6], a[7]);
                *(u32x4*)(act + (size_t)row * DFF + col0) = w;
            }
    }
};

struct TileInfo { const float* src; const float* gain; bf16_t* dst; int N, K, k0, n0, drow0; };
__device__ __forceinline__ TileInfo tile_info(const Params& P, int t) {
    const int T_IN = 16 * 44, T_OUT = 16 * 16, T_G = 16 * 44;
    TileInfo ti;
    int i = t;
    if (i < T_IN) { const int kt = i / 44, ntl = i % 44; ti = TileInfo{P.w_in, P.g1, (bf16_t*)(P.ws + WS_WIN), INW, DM, kt * 64, ntl * 64, ntl * 64}; return ti; }
    i -= T_IN;
    if (i < T_OUT) { const int kt = i / 16, ntl = i % 16; ti = TileInfo{P.w_out, nullptr, (bf16_t*)(P.ws + WS_WOUT), DM, DM, kt * 64, ntl * 64, ntl * 64}; return ti; }
    i -= T_OUT;
    if (i < 2 * T_G) { const int up = i >= T_G; if (up) i -= T_G; const int kt = i / 44, ntl = i % 44; const int f0 = ntl * 64;
        ti = TileInfo{up ? P.w_up : P.w_gate, P.g3, (bf16_t*)(P.ws + WS_WGU), DFF, DM, kt * 64, f0, (f0 >> 7) * 256 + (up ? 128 : 0) + (f0 & 127)}; return ti; }
    i -= 2 * T_G;
    { const int kt = i / 16, ntl = i % 16; ti = TileInfo{P.w_down, nullptr, (bf16_t*)(P.ws + WS_WDN), DM, DFF, kt * 64, ntl * 64, ntl * 64}; }
    return ti;
}
__device__ __forceinline__ void tile_load(const TileInfo& ti, int kr, int c4, f32x4& v0, f32x4& v1) {
    const float* p0 = ti.src + (size_t)(ti.k0 + kr) * ti.N + ti.n0 + c4 * 4;
    v0 = *(const f32x4*)p0; v1 = *(const f32x4*)(p0 + (size_t)32 * ti.N);
    if (ti.gain) { const float g0 = ti.gain[ti.k0 + kr], g1 = ti.gain[ti.k0 + kr + 32]; v0 *= g0; v1 *= g1; }
}

__device__ __forceinline__ void prep_weights(const Params& P, unsigned char* lds, int t0, int t1, int j, int stride) {
    const int tid = threadIdx.x;
    float* tile = (float*)lds;
    const int kr = tid >> 4, c4 = tid & 15, n = tid >> 3, kg = tid & 7;
    int t = t0 + j;
    f32x4 v0, v1; TileInfo cur;
    if (t < t1) { cur = tile_info(P, t); tile_load(cur, kr, c4, v0, v1); }
    for (; t < t1; t += stride) {
        __syncthreads();
        *(f32x4*)(tile + kr * 68 + c4 * 4) = v0; *(f32x4*)(tile + (kr + 32) * 68 + c4 * 4) = v1;
        const TileInfo me = cur;
        if (t + stride < t1) { cur = tile_info(P, t + stride); tile_load(cur, kr, c4, v0, v1); }
        __syncthreads();
        float x[8];
#pragma unroll
        for (int jj = 0; jj < 8; ++jj) x[jj] = tile[(kg * 8 + jj) * 68 + n];
        u32x4 o; o.x = cvt_pk_bf16(x[0], x[1]); o.y = cvt_pk_bf16(x[2], x[3]); o.z = cvt_pk_bf16(x[4], x[5]); o.w = cvt_pk_bf16(x[6], x[7]);
        *(u32x4*)(me.dst + (size_t)(me.drow0 + n) * me.K + me.k0 + kg * 8) = o;
    }
}

__device__ __forceinline__ void phase_prep(const Params& P, unsigned char* lds) {
    const int tid = threadIdx.x, w = __builtin_amdgcn_readfirstlane(tid >> 6), lane = tid & 63;
    {
        bf16_t* xb = (bf16_t*)(P.ws + WS_XB); float* rstd1 = (float*)(P.ws + WS_RSTD1);
        const int NW = gridDim.x * 8;
        for (int rowa = blockIdx.x * 8 + w; rowa < MP; rowa += 4 * NW) {
            f32x4 v[4][4];
#pragma unroll
            for (int r = 0; r < 4; ++r) {
                const int row = rowa + r * NW;
                const float* src = row < TP ? P.xp + (size_t)row * DM : (row < TP + NS ? P.xs + (size_t)(row - TP) * DM : nullptr);
#pragma unroll
                for (int i = 0; i < 4; ++i) { v[r][i] = (f32x4){0.f, 0.f, 0.f, 0.f}; if (src) v[r][i] = __builtin_nontemporal_load((const f32x4*)(src + i * 256 + lane * 4)); }
            }
#pragma unroll
            for (int r = 0; r < 4; ++r) {
                const int row = rowa + r * NW;
                if (row < MP) {
                    float ss = 0.f;
#pragma unroll
                    for (int i = 0; i < 4; ++i) {
                        const f32x4 x = v[r][i];
                        ss += x[0] * x[0] + x[1] * x[1] + x[2] * x[2] + x[3] * x[3];
                        u32x2 o; o.x = cvt_pk_bf16(x[0], x[1]); o.y = cvt_pk_bf16(x[2], x[3]);
                        *(u32x2*)(xb + (size_t)row * DM + i * 256 + lane * 4) = o;
                    }
                    ss = wave_sum(ss);
                    if (lane == 0) rstd1[row] = rsqrtf(ss * (1.0f / DM) + EPS);
                }
            }
        }
    }
    prep_weights(P, lds, 0, 16 * 44, blockIdx.x, gridDim.x);
    if (blockIdx.x == 0) {
        float* lb = (float*)(P.ws + WS_LB);
        const float a = P.rec_lb[tid], b = P.rec_lb[512 + tid];
        lb[tid] = 1.0f / (1.0f + expf(b - a));
    }
}

__device__ __forceinline__ void attn_prompt_item(const Params& P, unsigned char* lds, int item) {
    const int tid = threadIdx.x, w = __builtin_amdgcn_readfirstlane(tid >> 6), lane = tid & 63, fr = lane & 15, fq = lane >> 4;
    const int hkv = item & 1, nb = (item >> 1) & 63, b = item >> 7;
    bf16_t* Ks = (bf16_t*)lds;
    bf16_t* Vt = (bf16_t*)(lds + 36864);
    const bf16_t* proj = (const bf16_t*)(P.ws + WS_PROJ);
    bf16_t* mix = (bf16_t*)(P.ws + WS_MIX);
    const int h = hkv * 4 + (w >> 1);
    const bf16_t* qbase = proj + ((size_t)b * SEQ + nb * 128 + (w & 1) * 64 + fr) * INW + h * 64 + fq * 8;
    bf16x8 nq0 = *(const bf16x8*)qbase, nq1 = *(const bf16x8*)(qbase + 32);
    __syncthreads();
    {
        u32x4 kvs[4], vvs[4];
#pragma unroll
        for (int u = 0; u < 4; ++u) {
            const int c = tid + u * 512, r = c >> 3, ch = c & 7;
            kvs[u] = (u32x4){0u, 0u, 0u, 0u}; vvs[u] = (u32x4){0u, 0u, 0u, 0u};
            if (nb > 0 || r >= 128) {
                const size_t row = (size_t)b * SEQ + (size_t)((nb - 1) * 128 + r);
                const bf16_t* pr = proj + row * INW + 512 + hkv * 64 + ch * 8;
                kvs[u] = *(const u32x4*)pr; vvs[u] = *(const u32x4*)(pr + 128);
            }
        }
#pragma unroll
        for (int u = 0; u < 4; ++u) {
            const int c = tid + u * 512, r = c >> 3, ch = c & 7;
            const u32x4 kv = kvs[u], vv = vvs[u];
            *(u32x4*)(Ks + r * 72 + ch * 8) = kv;
#pragma unroll
            for (int i = 0; i < 8; ++i) Vt[(ch * 8 + i) * 264 + r] = (bf16_t)(vv[i >> 1] >> ((i & 1) * 16));
            if (nb == 63 && r >= 128) {
                const size_t o = ((size_t)(b * 128 + (r - 128)) * 2 + hkv) * 64 + ch * 8;
                float* ok = P.out + OUT_KP + o; float* ov = P.out + OUT_VP + o;
                *(f32x4*)ok = (f32x4){lo_bf(kv[0]), hi_bf(kv[0]), lo_bf(kv[1]), hi_bf(kv[1])}; *(f32x4*)(ok + 4) = (f32x4){lo_bf(kv[2]), hi_bf(kv[2]), lo_bf(kv[3]), hi_bf(kv[3])};
                *(f32x4*)ov = (f32x4){lo_bf(vv[0]), hi_bf(vv[0]), lo_bf(vv[1]), hi_bf(vv[1])}; *(f32x4*)(ov + 4) = (f32x4){lo_bf(vv[2]), hi_bf(vv[2]), lo_bf(vv[3]), hi_bf(vv[3])};
            }
        }
    }
    __syncthreads();
    const float sink2 = P.sinks[h] * 1.4426950408889634f;
    for (int it = 0; it < 4; ++it) {
        const int qi0 = (w & 1) * 64 + it * 16, kt0 = qi0 >> 4;
        const bf16x8 bq0 = nq0, bq1 = nq1;
        if (it < 3) { const bf16_t* qp = qbase + (size_t)(it + 1) * 16 * INW; nq0 = *(const bf16x8*)qp; nq1 = *(const bf16x8*)(qp + 32); }
        f32x4 s[9];
#pragma unroll
        for (int j = 0; j < 9; ++j) {
            const bf16_t* kp = Ks + ((kt0 + j) * 16 + fr) * 72 + fq * 8;
            f32x4 a = {0.f, 0.f, 0.f, 0.f};
            a = MFMA16(*(const bf16x8*)kp, bq0, a);
            a = MFMA16(*(const bf16x8*)(kp + 32), bq1, a);
            s[j] = a;
        }
        float m = sink2;
        if (nb > 0) {
#pragma unroll
            for (int e = 0; e < 4; ++e) {
                s[0][e] = (fq * 4 + e > fr) ? s[0][e] : -1e30f;
                s[8][e] = (fq * 4 + e <= fr) ? s[8][e] : -1e30f;
            }
        } else {
            const int qi = qi0 + fr;
#pragma unroll
            for (int j = 0; j < 9; ++j)
#pragma unroll
                for (int e = 0; e < 4; ++e) {
                    const int ki = (kt0 + j) * 16 + fq * 4 + e;
                    const bool valid = (ki > qi) && (ki <= qi + 128) && (ki >= 128);
                    s[j][e] = valid ? s[j][e] : -1e30f;
                }
        }
#pragma unroll
        for (int j = 0; j < 9; ++j)
#pragma unroll
            for (int e = 0; e < 4; ++e) m = fmaxf(m, s[j][e]);
        m = xmax_rows(m);
        float sum = 0.f;
#pragma unroll
        for (int j = 0; j < 9; ++j)
#pragma unroll
            for (int e = 0; e < 4; ++e) { const float p = __builtin_amdgcn_exp2f(s[j][e] - m); s[j][e] = p; sum += p; }
        sum = xsum_rows(sum);
        const float inv = 1.0f / (sum + __builtin_amdgcn_exp2f(sink2 - m));
        f32x4 o[4];
#pragma unroll
        for (int dt = 0; dt < 4; ++dt) o[dt] = (f32x4){0.f, 0.f, 0.f, 0.f};
#pragma unroll
        for (int kk = 0; kk < 5; ++kk) {
            const int j0 = 2 * kk, j1 = 2 * kk + 1, j1c = j1 < 9 ? j1 : 8;
            u32x4 pa;
            pa.x = cvt_pk_bf16(s[j0][0], s[j0][1]); pa.y = cvt_pk_bf16(s[j0][2], s[j0][3]);
            if (j1 < 9) { pa.z = cvt_pk_bf16(s[j1c][0], s[j1c][1]); pa.w = cvt_pk_bf16(s[j1c][2], s[j1c][3]); } else { pa.z = 0u; pa.w = 0u; }
            bf16x8 aop; __builtin_memcpy(&aop, &pa, 16);
#pragma unroll
            for (int dt = 0; dt < 4; ++dt) {
                const bf16_t* vp = Vt + (dt * 16 + fr) * 264 + fq * 4;
                u32x2 v0 = *(const u32x2*)(vp + (kt0 + j0) * 16), v1 = *(const u32x2*)(vp + (kt0 + j1c) * 16);
                u32x4 vb; vb.x = v0.x; vb.y = v0.y; vb.z = v1.x; vb.w = v1.y;
                bf16x8 bop; __builtin_memcpy(&bop, &vb, 16);
                o[dt] = MFMA16(bop, aop, o[dt]);
            }
        }
#pragma unroll
        for (int dt = 0; dt < 4; ++dt) {
            u32x2 ow; ow.x = cvt_pk_bf16(o[dt][0] * inv, o[dt][1] * inv); ow.y = cvt_pk_bf16(o[dt][2] * inv, o[dt][3] * inv);
            *(u32x2*)(mix + ((size_t)b * SEQ + nb * 128 + qi0 + fr) * DM + h * 64 + dt * 16 + fq * 4) = ow;
        }
    }
}

__device__ __forceinline__ void dec_attn_item(const Params& P, unsigned char* lds, int item) {
    const int tid = threadIdx.x, w = __builtin_amdgcn_readfirstlane(tid >> 6), lane = tid & 63;
    const int hkv = item & 1, b = item >> 1;
    float* Kl = (float*)lds;
    float* Vl = (float*)(lds + 33280);
    float* Pb = (float*)(lds + 66048);
    float* Qs = (float*)(lds + 66048 + 2048);
    const bf16_t* pr = (const bf16_t*)(P.ws + WS_PROJ) + (size_t)(TP + b) * INW;
    bf16_t* mix = (bf16_t*)(P.ws + WS_MIX);
    const float* ck = P.ck + (size_t)b * 16384 + hkv * 64; const float* cv = P.cv + (size_t)b * 16384 + hkv * 64;
    float* ok = P.out + OUT_KS + (size_t)b * 16384 + hkv * 64; float* ov = P.out + OUT_VS + (size_t)b * 16384 + hkv * 64;
    __syncthreads();
    {
        float kr[16], vr[16];
#pragma unroll
        for (int u = 0; u < 16; ++u) {
            const int idx = tid + u * 512, r = idx >> 6, c = idx & 63;
            if (r < 127) { kr[u] = ck[(r + 1) * 128 + c]; vr[u] = cv[(r + 1) * 128 + c]; } else { kr[u] = bf2f(pr[512 + hkv * 64 + c]); vr[u] = bf2f(pr[640 + hkv * 64 + c]); }
        }
#pragma unroll
        for (int u = 0; u < 16; ++u) {
            const int idx = tid + u * 512, r = idx >> 6, c = idx & 63;
            Kl[r * 65 + c] = kr[u]; Vl[r * 64 + c] = vr[u]; ok[r * 128 + c] = kr[u]; ov[r * 128 + c] = vr[u];
        }
    }
    const int h = hkv * 4 + (w & 3);
    if (w < 4) Qs[w * 64 + lane] = bf2f(pr[h * 64 + lane]);
    __syncthreads();
    float sum = 1.f;
    if (w < 4) {
        const float sink = P.sinks[h] * 1.4426950408889634f;
        float s0 = 0.f, s1 = 0.f;
#pragma unroll 8
        for (int d = 0; d < 64; ++d) { const float q = Qs[w * 64 + d]; s0 += q * Kl[lane * 65 + d]; s1 += q * Kl[(lane + 64) * 65 + d]; }
        const float m = fmaxf(sink, wave_max(fmaxf(s0, s1)));
        const float p0 = __builtin_amdgcn_exp2f(s0 - m), p1 = __builtin_amdgcn_exp2f(s1 - m);
        sum = wave_sum(p0 + p1) + __builtin_amdgcn_exp2f(sink - m);
        Pb[w * 128 + lane] = p0; Pb[w * 128 + 64 + lane] = p1;
    }
    __syncthreads();
    if (w < 4) {
        float o = 0.f;
#pragma unroll 8
        for (int key = 0; key < 128; ++key) o += Pb[w * 128 + key] * Vl[key * 64 + lane];
        mix[(size_t)(TP + b) * DM + h * 64 + lane] = f2bf(o / sum);
    }
}

__device__ __forceinline__ void dec_hgrn_item(const Params& P, unsigned char* lds, int item) {
    const int tid = threadIdx.x, w = __builtin_amdgcn_readfirstlane(tid >> 6), lane = tid & 63;
    const int h = item & 3, b = item >> 2;
    float* red = (float*)lds;
    float* ssb = (float*)(lds + 8192);
    const bf16_t* pr = (const bf16_t*)(P.ws + WS_PROJ) + (size_t)(TP + b) * INW;
    bf16_t* mix = (bf16_t*)(P.ws + WS_MIX);
    __syncthreads();
    const int v4 = tid & 31, kg = tid >> 5;
    f32x4 iv;
#pragma unroll
    for (int j = 0; j < 4; ++j) iv[j] = bf2f(pr[1792 + h * 128 + v4 * 4 + j]);
    const float* S0 = P.st + (size_t)(b * 4 + h) * 16384; float* So = P.out + OUT_SS + (size_t)(b * 4 + h) * 16384;
    f32x4 oacc = {0.f, 0.f, 0.f, 0.f};
    f32x4 sv[8]; float fv[8], qv[8];
#pragma unroll
    for (int kk = 0; kk < 8; ++kk) {
        const int dk = kg * 8 + kk;
        sv[kk] = *(const f32x4*)(S0 + dk * 128 + v4 * 4);
        fv[kk] = bf2f(pr[1280 + h * 128 + dk]); qv[kk] = bf2f(pr[768 + h * 128 + dk]);
    }
#pragma unroll
    for (int kk = 0; kk < 8; ++kk) {
        const int dk = kg * 8 + kk;
        const float f = __expf(fv[kk]), kq = 1.0f - f;
        const f32x4 sn = sv[kk] * f + iv * kq;
        *(f32x4*)(So + dk * 128 + v4 * 4) = sn;
        oacc += sn * qv[kk];
    }
    *(f32x4*)(red + kg * 128 + v4 * 4) = oacc;
    __syncthreads();
    float o = 0.f;
    if (tid < 128) {
#pragma unroll
        for (int g = 0; g < 16; ++g) o += red[g * 128 + tid];
        const float part = wave_sum(o * o);
        if (lane == 0) ssb[w] = part;
    }
    __syncthreads();
    if (tid < 128) {
        const float r = rsqrtf((ssb[0] + ssb[1]) * (1.0f / 128.0f) + EPS);
        const float g = bf2f(pr[2304 + h * 128 + tid]);
        mix[(size_t)(TP + b) * DM + 512 + h * 128 + tid] = f2bf(o * r * P.rec_norm[h * 128 + tid] * g);
    }
}

template <bool OUT>
__device__ __forceinline__ void hgrn_item(const Params& P, unsigned char* lds, int item) {
    const int tid = threadIdx.x, w = __builtin_amdgcn_readfirstlane(tid >> 6), lane = tid & 63, fr = lane & 15, fq = lane >> 4;
    const int sc = item & 31, s = item >> 5, h = s & 3, b = s >> 2;
    bf16_t* Qs = (bf16_t*)(lds);
    bf16_t* Qp = (bf16_t*)(lds + 8704);
    bf16_t* Kp = (bf16_t*)(lds + 17408);
    bf16_t* Kt = (bf16_t*)(lds + 26112);
    bf16_t* It = (bf16_t*)(lds + 36352);
    bf16_t* Am = (bf16_t*)(lds + 46592);
    float* dl = (float*)(lds + 49152);
    float* tot = (float*)(lds + 49664);
    float* Ob = (float*)(lds + 53760);
    const bf16_t* proj = (const bf16_t*)(P.ws + WS_PROJ);
    bf16_t* mix = (bf16_t*)(P.ws + WS_MIX);
    float* HU = (float*)(P.ws + WS_HU) + (size_t)item * 16384;
    float* HD = (float*)(P.ws + WS_HD) + (size_t)item * 128;
    __syncthreads();
    f32x4 S[8];
#pragma unroll
    for (int m = 0; m < 8; ++m)
#pragma unroll
        for (int e = 0; e < 4; ++e) S[m][e] = OUT ? HU[(m * 16 + fq * 4 + e) * 128 + w * 16 + fr] : 0.f;
    const int cp = tid & 63, tg = w, c0 = 2 * cp;
    float dtot0 = 0.f, dtot1 = 0.f;
    const float rn0 = OUT ? P.rec_norm[h * 128 + c0] : 0.f, rn1 = OUT ? P.rec_norm[h * 128 + c0 + 1] : 0.f;
    unsigned nlw[4], nqw[4], niw[4], ngw[4];
    {
        const size_t row0 = (size_t)b * SEQ + sc * 256;
#pragma unroll
        for (int tt = 0; tt < 4; ++tt) {
            const bf16_t* rp = proj + (row0 + tg * 4 + tt) * INW + h * 128 + c0;
            nlw[tt] = *(const unsigned*)(rp + 1280); niw[tt] = *(const unsigned*)(rp + 1792);
            if (OUT) { nqw[tt] = *(const unsigned*)(rp + 768); ngw[tt] = *(const unsigned*)(rp + 2304); }
        }
    }
    for (int sub = 0; sub < 8; ++sub) {
        const size_t row0 = (size_t)b * SEQ + sc * 256 + sub * 32;
        float l0[4], l1[4], q0[4], q1[4]; unsigned iw[4], gw[4];
#pragma unroll
        for (int tt = 0; tt < 4; ++tt) {
            l0[tt] = lo_bf(nlw[tt]) * 1.4426950408889634f; l1[tt] = hi_bf(nlw[tt]) * 1.4426950408889634f; iw[tt] = niw[tt];
            if (OUT) { q0[tt] = lo_bf(nqw[tt]); q1[tt] = hi_bf(nqw[tt]); gw[tt] = ngw[tt]; }
        }
        if (sub < 7) {
#pragma unroll
            for (int tt = 0; tt < 4; ++tt) {
                const bf16_t* rp = proj + (row0 + 32 + tg * 4 + tt) * INW + h * 128 + c0;
                nlw[tt] = *(const unsigned*)(rp + 1280); niw[tt] = *(const unsigned*)(rp + 1792);
                if (OUT) { nqw[tt] = *(const unsigned*)(rp + 768); ngw[tt] = *(const unsigned*)(rp + 2304); }
            }
        }
        float c0s[4], c1s[4];
        c0s[0] = l0[0]; c1s[0] = l1[0];
#pragma unroll
        for (int tt = 1; tt < 4; ++tt) { c0s[tt] = c0s[tt - 1] + l0[tt]; c1s[tt] = c1s[tt - 1] + l1[tt]; }
        tot[tg * 128 + c0] = c0s[3]; tot[tg * 128 + c0 + 1] = c1s[3];
        __syncthreads();
        float base0 = 0.f, base1 = 0.f, ref0 = 0.f, ref1 = 0.f, last0 = 0.f, last1 = 0.f;
#pragma unroll
        for (int g = 0; g < 8; ++g) {
            const float t0 = tot[g * 128 + c0], t1 = tot[g * 128 + c0 + 1];
            if (g < tg) { base0 += t0; base1 += t1; }
            if (g < 4) { ref0 += t0; ref1 += t1; }
            last0 += t0; last1 += t1;
        }
        float kt0[4], kt1[4];
#pragma unroll
        for (int tt = 0; tt < 4; ++tt) {
            const int t = tg * 4 + tt;
            const float b0 = base0 + c0s[tt], b1 = base1 + c1s[tt];
            const float k0 = 1.0f - __builtin_amdgcn_exp2f(l0[tt]), k1 = 1.0f - __builtin_amdgcn_exp2f(l1[tt]);
            kt0[tt] = k0 * __builtin_amdgcn_exp2f(last0 - b0); kt1[tt] = k1 * __builtin_amdgcn_exp2f(last1 - b1);
            if (OUT) {
                *(unsigned*)(Qs + t * 136 + c0) = cvt_pk_bf16(q0[tt] * __builtin_amdgcn_exp2f(b0), q1[tt] * __builtin_amdgcn_exp2f(b1));
                const float e0 = fminf(fmaxf(b0 - ref0, -115.f), 115.f), e1 = fminf(fmaxf(b1 - ref1, -115.f), 115.f);
                *(unsigned*)(Qp + t * 136 + c0) = cvt_pk_bf16(q0[tt] * __builtin_amdgcn_exp2f(e0), q1[tt] * __builtin_amdgcn_exp2f(e1));
                *(unsigned*)(Kp + t * 136 + c0) = cvt_pk_bf16(k0 * __builtin_amdgcn_exp2f(-e0), k1 * __builtin_amdgcn_exp2f(-e1));
            }
        }
        {
            u32x2 kw0, kw1, iw0, iw1;
            kw0.x = cvt_pk_bf16(kt0[0], kt0[1]); kw0.y = cvt_pk_bf16(kt0[2], kt0[3]); kw1.x = cvt_pk_bf16(kt1[0], kt1[1]); kw1.y = cvt_pk_bf16(kt1[2], kt1[3]);
            iw0.x = (iw[0] & 0xFFFFu) | (iw[1] << 16); iw0.y = (iw[2] & 0xFFFFu) | (iw[3] << 16);
            iw1.x = (iw[0] >> 16) | (iw[1] & 0xFFFF0000u); iw1.y = (iw[2] >> 16) | (iw[3] & 0xFFFF0000u);
            *(u32x2*)(Kt + c0 * 40 + tg * 4) = kw0; *(u32x2*)(Kt + (c0 + 1) * 40 + tg * 4) = kw1;
            *(u32x2*)(It + c0 * 40 + tg * 4) = iw0; *(u32x2*)(It + (c0 + 1) * 40 + tg * 4) = iw1;
        }
        if (tg == 0) { dl[c0] = __builtin_amdgcn_exp2f(last0); dl[c0 + 1] = __builtin_amdgcn_exp2f(last1); dtot0 += last0; dtot1 += last1; }
        __syncthreads();
        f32x4 o[2];
        if (OUT) {
            o[0] = (f32x4){0.f, 0.f, 0.f, 0.f}; o[1] = (f32x4){0.f, 0.f, 0.f, 0.f};
#pragma unroll
            for (int kk = 0; kk < 4; ++kk) {
                const int m0 = 2 * kk, m1 = 2 * kk + 1;
                u32x4 sb; sb.x = cvt_pk_bf16(S[m0][0], S[m0][1]); sb.y = cvt_pk_bf16(S[m0][2], S[m0][3]); sb.z = cvt_pk_bf16(S[m1][0], S[m1][1]); sb.w = cvt_pk_bf16(S[m1][2], S[m1][3]);
                bf16x8 bop; __builtin_memcpy(&bop, &sb, 16);
#pragma unroll
                for (int mt = 0; mt < 2; ++mt) {
                    const bf16_t* ap = Qs + (mt * 16 + fr) * 136 + fq * 4;
                    const u32x2 a0 = *(const u32x2*)(ap + m0 * 16), a1 = *(const u32x2*)(ap + m1 * 16);
                    u32x4 av; av.x = a0.x; av.y = a0.y; av.z = a1.x; av.w = a1.y;
                    bf16x8 aop; __builtin_memcpy(&aop, &av, 16);
                    o[mt] = MFMA16(aop, bop, o[mt]);
                }
            }
            if (w < 3) {
                const int mt = w > 0 ? 1 : 0, nt = w > 1 ? 1 : 0;
                f32x4 a = {0.f, 0.f, 0.f, 0.f};
#pragma unroll
                for (int ks = 0; ks < 4; ++ks) {
                    const bf16x8 aop = *(const bf16x8*)(Qp + (mt * 16 + fr) * 136 + ks * 32 + fq * 8);
                    const bf16x8 bop = *(const bf16x8*)(Kp + (nt * 16 + fr) * 136 + ks * 32 + fq * 8);
                    a = MFMA16(aop, bop, a);
                }
#pragma unroll
                for (int e = 0; e < 4; ++e) {
                    const int t = mt * 16 + fq * 4 + e, sx = nt * 16 + fr;
                    Am[t * 40 + sx] = (sx <= t) ? f2bf(a[e]) : (bf16_t)0;
                }
            } else if (w == 3) {
#pragma unroll
                for (int e = 0; e < 4; ++e) Am[(fq * 4 + e) * 40 + 16 + fr] = (bf16_t)0;
            }
            __syncthreads();
        }
        const bf16x8 bi = *(const bf16x8*)(It + (w * 16 + fr) * 40 + fq * 8);
        if (OUT) {
#pragma unroll
            for (int mt = 0; mt < 2; ++mt) {
                const bf16x8 aop = *(const bf16x8*)(Am + (mt * 16 + fr) * 40 + fq * 8);
                o[mt] = MFMA16(aop, bi, o[mt]);
            }
        }
#pragma unroll
        for (int m = 0; m < 8; ++m) {
            const f32x4 dv = *(const f32x4*)(dl + m * 16 + fq * 4);
            S[m] = S[m] * dv;
            const bf16x8 aop = *(const bf16x8*)(Kt + (m * 16 + fr) * 40 + fq * 8);
            S[m] = MFMA16(aop, bi, S[m]);
        }
        if (OUT) {
#pragma unroll
            for (int mt = 0; mt < 2; ++mt)
#pragma unroll
                for (int e = 0; e < 4; ++e) Ob[(mt * 16 + fq * 4 + e) * 132 + w * 16 + fr] = o[mt][e];
            __syncthreads();
#pragma unroll
            for (int tt = 0; tt < 4; ++tt) {
                const int t = w * 4 + tt;
                const float v0 = Ob[t * 132 + 2 * lane], v1 = Ob[t * 132 + 2 * lane + 1];
                const float ssq = wave_sum(v0 * v0 + v1 * v1);
                const float r = rsqrtf(ssq * (1.0f / 128.0f) + EPS);
                *(unsigned*)(mix + (row0 + t) * DM + 512 + h * 128 + 2 * lane) = cvt_pk_bf16(v0 * r * rn0 * lo_bf(gw[tt]), v1 * r * rn1 * hi_bf(gw[tt]));
            }
        }
    }
    if (!OUT) {
#pragma unroll
        for (int m = 0; m < 8; ++m)
#pragma unroll
            for (int e = 0; e < 4; ++e) HU[(m * 16 + fq * 4 + e) * 128 + w * 16 + fr] = S[m][e];
        if (tg == 0) { HD[c0] = __builtin_amdgcn_exp2f(dtot0); HD[c0 + 1] = __builtin_amdgcn_exp2f(dtot1); }
    }
}

__device__ __forceinline__ void hgrn_state_item(const Params& P, unsigned char* lds, int item) {
    const int tid = threadIdx.x, w = __builtin_amdgcn_readfirstlane(tid >> 6), lane = tid & 63, fr = lane & 15, fq = lane >> 4;
    const int sc = item & 31, s = item >> 5, h = s & 3, b = s >> 2;
    bf16_t* Kt = (bf16_t*)(lds);
    bf16_t* It = (bf16_t*)(lds + 34816);
    float* dl = (float*)(lds + 69632);
    float* tot = (float*)(lds + 70144);
    const bf16_t* proj = (const bf16_t*)(P.ws + WS_PROJ);
    float* HU = (float*)(P.ws + WS_HU) + (size_t)item * 16384;
    float* HD = (float*)(P.ws + WS_HD) + (size_t)item * 128;
    const int c0 = 2 * lane, tg = w;
    f32x4 S[8];
#pragma unroll
    for (int m = 0; m < 8; ++m) S[m] = (f32x4){0.f, 0.f, 0.f, 0.f};
    float dtot0 = 0.f, dtot1 = 0.f;
    __syncthreads();
    for (int step = 0; step < 2; ++step) {
        const size_t row0 = (size_t)b * SEQ + sc * 256 + step * 128 + tg * 16;
        unsigned lw[16], iw[16];
#pragma unroll
        for (int tt = 0; tt < 16; ++tt) {
            const bf16_t* rp = proj + (row0 + tt) * INW + h * 128 + c0;
            lw[tt] = *(const unsigned*)(rp + 1280); iw[tt] = *(const unsigned*)(rp + 1792);
        }
        float c0s[16], c1s[16];
        float la[16], lb2[16];
#pragma unroll
        for (int tt = 0; tt < 16; ++tt) { la[tt] = lo_bf(lw[tt]) * 1.4426950408889634f; lb2[tt] = hi_bf(lw[tt]) * 1.4426950408889634f; }
        c0s[0] = la[0]; c1s[0] = lb2[0];
#pragma unroll
        for (int tt = 1; tt < 16; ++tt) { c0s[tt] = c0s[tt - 1] + la[tt]; c1s[tt] = c1s[tt - 1] + lb2[tt]; }
        tot[tg * 128 + c0] = c0s[15]; tot[tg * 128 + c0 + 1] = c1s[15];
        __syncthreads();
        float base0 = 0.f, base1 = 0.f, last0 = 0.f, last1 = 0.f;
#pragma unroll
        for (int g = 0; g < 8; ++g) {
            const float t0 = tot[g * 128 + c0], t1 = tot[g * 128 + c0 + 1];
            if (g < tg) { base0 += t0; base1 += t1; }
            last0 += t0; last1 += t1;
        }
        unsigned kw0[8], kw1[8], iw0[8], iw1[8];
#pragma unroll
        for (int t2 = 0; t2 < 8; ++t2) {
            float ka[2], kb[2];
#pragma unroll
            for (int u = 0; u < 2; ++u) {
                const int tt = 2 * t2 + u;
                const float b0 = base0 + c0s[tt], b1 = base1 + c1s[tt];
                ka[u] = (1.0f - __builtin_amdgcn_exp2f(la[tt])) * __builtin_amdgcn_exp2f(last0 - b0);
                kb[u] = (1.0f - __builtin_amdgcn_exp2f(lb2[tt])) * __builtin_amdgcn_exp2f(last1 - b1);
            }
            kw0[t2] = cvt_pk_bf16(ka[0], ka[1]); kw1[t2] = cvt_pk_bf16(kb[0], kb[1]);
            iw0[t2] = (iw[2 * t2] & 0xFFFFu) | (iw[2 * t2 + 1] << 16);
            iw1[t2] = (iw[2 * t2] >> 16) | (iw[2 * t2 + 1] & 0xFFFF0000u);
        }
#pragma unroll
        for (int q = 0; q < 2; ++q) {
            u32x4 a, bq, c, d;
            a.x = kw0[4 * q]; a.y = kw0[4 * q + 1]; a.z = kw0[4 * q + 2]; a.w = kw0[4 * q + 3];
            bq.x = kw1[4 * q]; bq.y = kw1[4 * q + 1]; bq.z = kw1[4 * q + 2]; bq.w = kw1[4 * q + 3];
            c.x = iw0[4 * q]; c.y = iw0[4 * q + 1]; c.z = iw0[4 * q + 2]; c.w = iw0[4 * q + 3];
            d.x = iw1[4 * q]; d.y = iw1[4 * q + 1]; d.z = iw1[4 * q + 2]; d.w = iw1[4 * q + 3];
            *(u32x4*)(Kt + c0 * 136 + tg * 16 + q * 8) = a; *(u32x4*)(Kt + (c0 + 1) * 136 + tg * 16 + q * 8) = bq;
            *(u32x4*)(It + c0 * 136 + tg * 16 + q * 8) = c; *(u32x4*)(It + (c0 + 1) * 136 + tg * 16 + q * 8) = d;
        }
        if (tg == 0) { dl[c0] = __builtin_amdgcn_exp2f(last0); dl[c0 + 1] = __builtin_amdgcn_exp2f(last1); dtot0 += last0; dtot1 += last1; }
        __syncthreads();
        bf16x8 bi[4];
#pragma unroll
        for (int ks = 0; ks < 4; ++ks) bi[ks] = *(const bf16x8*)(It + (w * 16 + fr) * 136 + ks * 32 + fq * 8);
#pragma unroll
        for (int m = 0; m < 8; ++m) {
            const f32x4 dv = *(const f32x4*)(dl + m * 16 + fq * 4);
            S[m] = S[m] * dv;
#pragma unroll
            for (int ks = 0; ks < 4; ++ks) {
                const bf16x8 aop = *(const bf16x8*)(Kt + (m * 16 + fr) * 136 + ks * 32 + fq * 8);
                S[m] = MFMA16(aop, bi[ks], S[m]);
            }
        }
    }
#pragma unroll
    for (int m = 0; m < 8; ++m)
#pragma unroll
        for (int e = 0; e < 4; ++e) HU[(m * 16 + fq * 4 + e) * 128 + w * 16 + fr] = S[m][e];
    if (tg == 0) { HD[c0] = __builtin_amdgcn_exp2f(dtot0); HD[c0 + 1] = __builtin_amdgcn_exp2f(dtot1); }
}

__device__ __forceinline__ void phase_scan(const Params& P) {
    float* HU = (float*)(P.ws + WS_HU); const float* HD = (const float*)(P.ws + WS_HD);
    for (int e = blockIdx.x * 512 + threadIdx.x; e < 16 * 16384; e += gridDim.x * 512) {
        const int s = e >> 14, el = e & 16383, dk = el >> 7;
        float u[32], d[32];
#pragma unroll
        for (int sc = 0; sc < 32; ++sc) { const size_t it = (size_t)s * 32 + sc; u[sc] = HU[it * 16384 + el]; d[sc] = HD[it * 128 + dk]; }
        float carry = 0.f;
#pragma unroll
        for (int sc = 0; sc < 32; ++sc) {
            const size_t it = (size_t)s * 32 + sc;
            HU[it * 16384 + el] = carry;
            carry = d[sc] * carry + u[sc];
        }
        P.out[OUT_SP + e] = carry;
    }
}

__global__ void __launch_bounds__(512, 2) mk_fwd(Params P, int ph_lo, int ph_hi) {
    extern __shared__ __attribute__((aligned(16))) unsigned char shm[];
    cg::grid_group grid = cg::this_grid();
    const int tid = threadIdx.x, w = __builtin_amdgcn_readfirstlane(tid >> 6), lane = tid & 63;
#define IN_PH(p) (ph_lo <= (p) && (p) < ph_hi)
#define PH_LOOP(p) for (int rep = 0; rep < ((PROBE_DUP == (p)) ? 2 : 1); ++rep)
    volatile LAS unsigned* xst = (volatile LAS unsigned*)((LAS unsigned char*)shm + 131072);
    if (tid == 0) { xst[0] = 0u; xst[1] = 0u; }
    __syncthreads();
    (void)xcd_barrier_post((unsigned*)(P.ws + WS_BAR), xst);
#define XBAR() xcd_barrier((unsigned*)(P.ws + WS_BAR), (volatile LAS unsigned*)((LAS unsigned char*)shm + 131072))
#define PH_SYNC if (rep) XBAR()
#define SEAM(p) do { if (ph_lo <= (p) && (p) + 1 < ph_hi) XBAR(); } while (0)
    if (ph_hi > NPHASE + 1) grid.sync();
    if (PROBE_DUP == 100) { for (int r = 0; r < 10; ++r) XBAR(); }
    if (IN_PH(0)) PH_LOOP(0) { PH_SYNC; phase_prep(P, shm); }
    SEAM(0);
    if (IN_PH(1)) PH_LOOP(1) { PH_SYNC;
        pg8::Gemm g{(const bf16_t*)(P.ws + WS_XB), (const bf16_t*)(P.ws + WS_WIN), MP, INW, DM};
        pg8::StaticOrder S; S.init(MP, INW, DM, gridDim.x, blockIdx.x, 0);
        EpiIn E{(bf16_t*)(P.ws + WS_PROJ), (const float*)(P.ws + WS_RSTD1), (const float*)(P.ws + WS_LB)};
        pg8::gemm_phase<EpiIn>((LAS unsigned char*)shm, g, S, E);
        {
            const int G = gridDim.x, nfull = (MP / 256 * (INW / 256)) % G;
            const int total = 16 * 44 + 16 * 16 + 2 * 16 * 44 + 44 * 16;
            if (nfull == 0) prep_weights(P, shm, 16 * 44, total, blockIdx.x, G);
            else if ((int)blockIdx.x >= nfull) prep_weights(P, shm, 16 * 44, total, blockIdx.x - nfull, G - nfull);
        }
    }
    SEAM(1);
    if (IN_PH(2)) PH_LOOP(2) { PH_SYNC;
        for (int i = blockIdx.x; i < 512; i += gridDim.x) hgrn_state_item(P, shm, i);
        for (int i = blockIdx.x; i < 1280; i += gridDim.x) {
            if (i < 512) attn_prompt_item(P, shm, i);
            else if (i < 768) dec_attn_item(P, shm, i - 512);
            else dec_hgrn_item(P, shm, i - 768);
        }
    }
    SEAM(2);
    if (IN_PH(3)) phase_scan(P);
    SEAM(3);
    if (IN_PH(4)) PH_LOOP(4) { PH_SYNC;
        for (int i = blockIdx.x; i < 512; i += gridDim.x) hgrn_item<true>(P, shm, i);
    }
    SEAM(4);
    if (IN_PH(5)) PH_LOOP(5) { PH_SYNC;
        pg8::Gemm g{(const bf16_t*)(P.ws + WS_MIX), (const bf16_t*)(P.ws + WS_WOUT), MP, DM, DM};
        pg8::StaticOrder S; S.init(TP, DM, DM, gridDim.x, blockIdx.x, rep ? 0 : 4 * (DM / 256));
        EpiSq E{(bf16_t*)(P.ws + WS_MIXO), (float*)(P.ws + WS_SS2), (float*)(P.ws + WS_S2)};
        pg8::gemm_phase<EpiSq>((LAS unsigned char*)shm, g, S, E);
    }
    SEAM(5);
    if (IN_PH(6)) PH_LOOP(6) { PH_SYNC;
        bf16_t* x1b = (bf16_t*)(P.ws + WS_XB); float* rstd3 = (float*)(P.ws + WS_RSTD3);
        const bf16_t* mixo = (const bf16_t*)(P.ws + WS_MIXO); const float* ss2 = (const float*)(P.ws + WS_SS2);
        const int NW = gridDim.x * 8;
        for (int rb = blockIdx.x * 8 + w; rb < NS; rb += NW) {
            const int row = TP + rb;
            const float* sp = (const float*)(P.ws + WS_S2) + (size_t)rb * DM;
            f32x4 v[4]; float ssm = 0.f;
#pragma unroll
            for (int i = 0; i < 4; ++i) {
                v[i] = *(const f32x4*)(sp + i * 256 + lane * 4);
#pragma unroll
                for (int k = 1; k < 4; ++k) v[i] += *(const f32x4*)(sp + (size_t)k * (NS * DM) + i * 256 + lane * 4);
                ssm += v[i][0] * v[i][0] + v[i][1] * v[i][1] + v[i][2] * v[i][2] + v[i][3] * v[i][3];
            }
            const float r2 = rsqrtf(wave_sum(ssm) * (1.0f / DM) + EPS);
            float ss = 0.f;
#pragma unroll
            for (int i = 0; i < 4; ++i) {
                const u32x2 xw = *(const u32x2*)(x1b + (size_t)row * DM + i * 256 + lane * 4);
                const f32x4 gv = *(const f32x4*)(P.g2 + i * 256 + lane * 4);
                const float a0 = lo_bf(xw.x) + v[i][0] * r2 * gv[0], a1 = hi_bf(xw.x) + v[i][1] * r2 * gv[1], a2 = lo_bf(xw.y) + v[i][2] * r2 * gv[2], a3 = hi_bf(xw.y) + v[i][3] * r2 * gv[3];
                ss += a0 * a0 + a1 * a1 + a2 * a2 + a3 * a3;
                u32x2 o; o.x = cvt_pk_bf16(a0, a1); o.y = cvt_pk_bf16(a2, a3);
                *(u32x2*)(x1b + (size_t)row * DM + i * 256 + lane * 4) = o;
            }
            ss = wave_sum(ss);
            if (lane == 0) rstd3[row] = rsqrtf(ss * (1.0f / DM) + EPS);
        }
        for (int rowa = blockIdx.x * 8 + w; rowa < TP; rowa += 4 * NW) {
            u32x2 xw[4][4], mw[4][4]; float sv[4];
#pragma unroll
            for (int r = 0; r < 4; ++r) {
                const int row = min(rowa + r * NW, TP - 1);
                sv[r] = lane < 16 ? ss2[(size_t)row * 16 + lane] : 0.f;
#pragma unroll
                for (int i = 0; i < 4; ++i) { xw[r][i] = __builtin_nontemporal_load((const u32x2*)(x1b + (size_t)row * DM + i * 256 + lane * 4)); mw[r][i] = *(const u32x2*)(mixo + (size_t)row * DM + i * 256 + lane * 4); }
            }
#pragma unroll
            for (int r = 0; r < 4; ++r) {
                const int row = rowa + r * NW;
                const float r2 = rsqrtf(wave_sum(sv[r]) * (1.0f / DM) + EPS);
                float ss = 0.f;
                u32x2 o[4];
#pragma unroll
                for (int i = 0; i < 4; ++i) {
                    const f32x4 gv = *(const f32x4*)(P.g2 + i * 256 + lane * 4);
                    const float a0 = lo_bf(xw[r][i].x) + lo_bf(mw[r][i].x) * r2 * gv[0], a1 = hi_bf(xw[r][i].x) + hi_bf(mw[r][i].x) * r2 * gv[1];
                    const float a2 = lo_bf(xw[r][i].y) + lo_bf(mw[r][i].y) * r2 * gv[2], a3 = hi_bf(xw[r][i].y) + hi_bf(mw[r][i].y) * r2 * gv[3];
                    ss += a0 * a0 + a1 * a1 + a2 * a2 + a3 * a3;
                    o[i].x = cvt_pk_bf16(a0, a1); o[i].y = cvt_pk_bf16(a2, a3);
                }
                ss = wave_sum(ss);
                if (row < TP) {
#pragma unroll
                    for (int i = 0; i < 4; ++i) *(u32x2*)(x1b + (size_t)row * DM + i * 256 + lane * 4) = o[i];
                    if (lane == 0) rstd3[row] = rsqrtf(ss * (1.0f / DM) + EPS);
                }
            }
        }
    }
    SEAM(6);
    if (IN_PH(7)) PH_LOOP(7) { PH_SYNC;
        pg8::Gemm g{(const bf16_t*)(P.ws + WS_XB), (const bf16_t*)(P.ws + WS_WGU), MP, 2 * DFF, DM};
        pg8::StaticOrder S; S.init(TP, 2 * DFF, DM, gridDim.x, blockIdx.x, rep ? 0 : 22 * (DM / 256));
        EpiGU E{(bf16_t*)(P.ws + WS_PROJ), (const float*)(P.ws + WS_RSTD3), (float*)(P.ws + WS_S3)};
        pg8::gemm_phase<EpiGU>((LAS unsigned char*)shm, g, S, E);
    }
    SEAM(7);
    if (IN_PH(8)) PH_LOOP(8) { PH_SYNC;
        pg8::Gemm g{(const bf16_t*)(P.ws + WS_PROJ), (const bf16_t*)(P.ws + WS_WDN), MP, DM, DFF};
        pg8::StaticOrder S; S.init(TP, DM, DFF, gridDim.x, blockIdx.x, rep ? 0 : 4 * (DFF / 256));
        for (int i = 0;; ++i) {
            const long L = (long)i * gridDim.x + blockIdx.x;
            if (L >= 512 + S.nextra) break;
            if (L < 512) continue;
            const int ks = (int)((L - 512) / 4);
            const float* s3 = (const float*)(P.ws + WS_S3); const float* rstd3 = (const float*)(P.ws + WS_RSTD3);
            bf16_t* actp = (bf16_t*)(P.ws + WS_PROJ);
            for (int e = tid; e < 128 * 128; e += 512) {
                const int row = e >> 7, j = (e & 127) * 2, f = ks * 256 + j;
                const float rs = rstd3[TP + row];
                const float* gp = s3 + (size_t)row * (2 * DFF) + (f >> 7) * 256 + (f & 127);
                float g0 = gp[0], g1 = gp[1], u0 = gp[128], u1 = gp[129];
#pragma unroll
                for (int k = 1; k < 4; ++k) { const float* gk = gp + (size_t)k * (NS * 2 * DFF); g0 += gk[0]; g1 += gk[1]; u0 += gk[128]; u1 += gk[129]; }
                g0 *= rs; g1 *= rs; u0 *= rs; u1 *= rs;
                *(unsigned*)(actp + (size_t)(TP + row) * DFF + f) = cvt_pk_bf16(silu_f(g0) * u0, silu_f(g1) * u1);
            }
            asm volatile("s_waitcnt vmcnt(0)" ::: "memory");
            __syncthreads();
        }
        EpiSq E{(bf16_t*)(P.ws + WS_MIX), (float*)(P.ws + WS_SS4), (float*)(P.ws + WS_S4)};
        pg8::gemm_phase<EpiSq>((LAS unsigned char*)shm, g, S, E);
    }
    SEAM(8);
    if (IN_PH(9)) PH_LOOP(9) { PH_SYNC;
        const bf16_t* x1b = (const bf16_t*)(P.ws + WS_XB); const bf16_t* ffo = (const bf16_t*)(P.ws + WS_MIX); const float* ss4 = (const float*)(P.ws + WS_SS4);
        const int NW = gridDim.x * 8;
        for (int rb = blockIdx.x * 8 + w; rb < NS; rb += NW) {
            const float* sp = (const float*)(P.ws + WS_S4) + (size_t)rb * DM;
            f32x4 v[4]; float ssm = 0.f;
#pragma unroll
            for (int i = 0; i < 4; ++i) {
                v[i] = *(const f32x4*)(sp + i * 256 + lane * 4);
#pragma unroll
                for (int k = 1; k < 11; ++k) v[i] += *(const f32x4*)(sp + (size_t)k * (NS * DM) + i * 256 + lane * 4);
                ssm += v[i][0] * v[i][0] + v[i][1] * v[i][1] + v[i][2] * v[i][2] + v[i][3] * v[i][3];
            }
            const float r4 = rsqrtf(wave_sum(ssm) * (1.0f / DM) + EPS);
            float* dst = P.out + OUT_YS + (size_t)rb * DM;
#pragma unroll
            for (int i = 0; i < 4; ++i) {
                const u32x2 xw = *(const u32x2*)(x1b + (size_t)(TP + rb) * DM + i * 256 + lane * 4);
                const f32x4 gv = *(const f32x4*)(P.g4 + i * 256 + lane * 4);
                f32x4 y;
                y[0] = lo_bf(xw.x) + v[i][0] * r4 * gv[0]; y[1] = hi_bf(xw.x) + v[i][1] * r4 * gv[1]; y[2] = lo_bf(xw.y) + v[i][2] * r4 * gv[2]; y[3] = hi_bf(xw.y) + v[i][3] * r4 * gv[3];
                *(f32x4*)(dst + i * 256 + lane * 4) = y;
            }
        }
        for (int rowa = blockIdx.x * 8 + w; rowa < TP; rowa += 4 * NW) {
            u32x2 xw[4][4], fw[4][4]; float sv[4];
#pragma unroll
            for (int r = 0; r < 4; ++r) {
                const int row = min(rowa + r * NW, TP - 1);
                sv[r] = lane < 16 ? ss4[(size_t)row * 16 + lane] : 0.f;
#pragma unroll
                for (int i = 0; i < 4; ++i) { xw[r][i] = *(const u32x2*)(x1b + (size_t)row * DM + i * 256 + lane * 4); fw[r][i] = *(const u32x2*)(ffo + (size_t)row * DM + i * 256 + lane * 4); }
            }
#pragma unroll
            for (int r = 0; r < 4; ++r) {
                const int row = rowa + r * NW;
                const float r4 = rsqrtf(wave_sum(sv[r]) * (1.0f / DM) + EPS);
                if (row < TP) {
                    float* dst = P.out + OUT_YP + (size_t)row * DM;
#pragma unroll
                    for (int i = 0; i < 4; ++i) {
                        const f32x4 gv = *(const f32x4*)(P.g4 + i * 256 + lane * 4);
                        f32x4 y;
                        y[0] = lo_bf(xw[r][i].x) + lo_bf(fw[r][i].x) * r4 * gv[0]; y[1] = hi_bf(xw[r][i].x) + hi_bf(fw[r][i].x) * r4 * gv[1];
                        y[2] = lo_bf(xw[r][i].y) + lo_bf(fw[r][i].y) * r4 * gv[2]; y[3] = hi_bf(xw[r][i].y) + hi_bf(fw[r][i].y) * r4 * gv[3];
                        __builtin_nontemporal_store(y, (f32x4*)(dst + i * 256 + lane * 4));
                    }
                }
            }
        }
    }
#undef IN_PH
#undef SEAM
}

extern "C" void kernel_launch(void* const* d_in, const int* in_sizes, int n_in, void* d_out, int out_size, void* d_ws, size_t ws_size, hipStream_t stream) {
    static int grid = 0;
    if (grid == 0) {
        if (n_in != 17 || ws_size < WS_END) { fprintf(stderr, "kernel_launch: unexpected inputs (n_in %d, ws %zu, need %zu)\n", n_in, ws_size, (size_t)WS_END); grid = -1; return; }
        int dev = 0, cus = 0, per_cu = 0;
        hipGetDevice(&dev);
        hipDeviceGetAttribute(&cus, hipDeviceAttributeMultiprocessorCount, dev);
        if (hipFuncSetAttribute((const void*)mk_fwd, hipFuncAttributeMaxDynamicSharedMemorySize, LDS_BYTES) != hipSuccess) { fprintf(stderr, "kernel_launch: hipFuncSetAttribute failed\n"); grid = -1; return; }
        if (hipOccupancyMaxActiveBlocksPerMultiprocessor(&per_cu, (const void*)mk_fwd, 512, LDS_BYTES) != hipSuccess || per_cu < 1) { fprintf(stderr, "kernel_launch: occupancy query failed (%d)\n", per_cu); grid = -1; return; }
        grid = cus * per_cu;
    }
    if (grid < 0) return;
    if (hipMemsetAsync((char*)d_ws + WS_BAR, 0, 3456 * 4, stream) != hipSuccess) { fprintf(stderr, "kernel_launch: memset of the barrier words failed\n"); return; }
    Params p{};
    p.xp = (const float*)d_in[0]; p.xs = (const float*)d_in[1]; p.ck = (const float*)d_in[2]; p.cv = (const float*)d_in[3]; p.st = (const float*)d_in[4];
    p.w_in = (const float*)d_in[5]; p.w_out = (const float*)d_in[6]; p.w_gate = (const float*)d_in[7]; p.w_up = (const float*)d_in[8]; p.w_down = (const float*)d_in[9];
    p.g1 = (const float*)d_in[10]; p.g2 = (const float*)d_in[11]; p.g3 = (const float*)d_in[12]; p.g4 = (const float*)d_in[13];
    p.sinks = (const float*)d_in[14]; p.rec_lb = (const float*)d_in[15]; p.rec_norm = (const float*)d_in[16];
    p.out = (float*)d_out; p.ws = (unsigned char*)d_ws;
#if N_LAUNCH_MODE == 1
    for (int ph = 0; ph < NPHASE; ++ph) hipLaunchKernelGGL(mk_fwd, dim3(grid), dim3(512), LDS_BYTES, stream, p, ph, ph + 1);
#else
    int lo = 0, hi = NPHASE;
    void* args[] = {&p, &lo, &hi};
    hipError_t e = hipLaunchCooperativeKernel((const void*)mk_fwd, dim3(grid), dim3(512), args, LDS_BYTES, stream);
    if (e != hipSuccess) fprintf(stderr, "cooperative launch failed: %s (grid %d)\n", hipGetErrorString(e), grid);
#endif
}
```

```cpp
#include <hip/hip_runtime.h>
#include <hip/hip_cooperative_groups.h>
#include <cstdio>
namespace cg = cooperative_groups;

#define LAS __attribute__((address_space(3)))
typedef unsigned short bf16_t;
typedef short bf16x8 __attribute__((ext_vector_type(8)));
typedef short bf16x4 __attribute__((ext_vector_type(4)));
typedef float f32x4 __attribute__((ext_vector_type(4)));
typedef unsigned u32x4 __attribute__((ext_vector_type(4)));
typedef unsigned u32x2 __attribute__((ext_vector_type(2)));

#ifndef N_LAUNCH_MODE
#define N_LAUNCH_MODE 0
#endif

constexpr int DM = 1024, TP = 32768, SEQ = 8192, NS = 128, MP = TP + 256, INW = 2816, DFF = 2816;
constexpr float EPS = 1e-6f;
constexpr int NPHASE = 10;
#ifndef PROBE_DUP
#define PROBE_DUP -1
#endif
constexpr int LDS_BYTES = 131072 + 16;

constexpr size_t al(size_t x) { return (x + 255) & ~(size_t)255; }
constexpr size_t WS_XB = 0;
constexpr size_t WS_PROJ = WS_XB + al((size_t)MP * DM * 2);
constexpr size_t WS_MIX = WS_PROJ + al((size_t)MP * INW * 2);
constexpr size_t WS_MIXO = WS_MIX + al((size_t)MP * DM * 2);
constexpr size_t WS_WIN = WS_MIXO + al((size_t)MP * DM * 2);
constexpr size_t WS_WOUT = WS_WIN + al((size_t)INW * DM * 2);
constexpr size_t WS_WGU = WS_WOUT + al((size_t)DM * DM * 2);
constexpr size_t WS_WDN = WS_WGU + al((size_t)2 * DFF * DM * 2);
constexpr size_t WS_RSTD1 = WS_WDN + al((size_t)DM * DFF * 2);
constexpr size_t WS_RSTD3 = WS_RSTD1 + al((size_t)MP * 4);
constexpr size_t WS_SS2 = WS_RSTD3 + al((size_t)MP * 4);
constexpr size_t WS_SS4 = WS_SS2 + al((size_t)MP * 16 * 4);
constexpr size_t WS_ROPE = WS_SS4 + al((size_t)MP * 16 * 4);
constexpr size_t WS_LB = WS_ROPE + al((size_t)8193 * 8 * 8);
constexpr size_t WS_HU = WS_LB + al(512 * 4);
constexpr size_t WS_HD = WS_HU + al((size_t)16 * 32 * 16384 * 4);
constexpr size_t WS_S2 = WS_HD + al((size_t)16 * 32 * 128 * 4);
constexpr size_t WS_S4 = WS_S2 + al((size_t)4 * NS * DM * 4);
constexpr size_t WS_S3 = WS_S4 + al((size_t)11 * NS * DM * 4);
constexpr size_t WS_BAR = WS_S3 + al((size_t)4 * NS * 2 * DFF * 4);
constexpr size_t WS_END = WS_BAR + al((size_t)3456 * 4);

constexpr size_t OUT_YP = 0;
constexpr size_t OUT_YS = OUT_YP + (size_t)TP * DM;
constexpr size_t OUT_KP = OUT_YS + (size_t)NS * DM;
constexpr size_t OUT_VP = OUT_KP + 65536;
constexpr size_t OUT_SP = OUT_VP + 65536;
constexpr size_t OUT_KS = OUT_SP + 262144;
constexpr size_t OUT_VS = OUT_KS + 2097152;
constexpr size_t OUT_SS = OUT_VS + 2097152;

struct Params {
    const float *xp, *xs, *ck, *cv, *st, *w_in, *w_out, *w_gate, *w_up, *w_down, *g1, *g2, *g3, *g4, *sinks, *rec_lb, *rec_norm;
    float* out; unsigned char* ws;
};

__device__ __forceinline__ float bf2f(bf16_t b) { return __uint_as_float(((unsigned)b) << 16); }
typedef float f32x2 __attribute__((ext_vector_type(2)));
typedef __bf16 bf16x2_t __attribute__((ext_vector_type(2)));
__device__ __forceinline__ bf16_t f2bf(float f) { const __bf16 b = (__bf16)f; bf16_t r; __builtin_memcpy(&r, &b, 2); return r; }
__device__ __forceinline__ unsigned cvt_pk_bf16(float lo, float hi) { const f32x2 v = {lo, hi}; const bf16x2_t b = __builtin_convertvector(v, bf16x2_t); unsigned r; __builtin_memcpy(&r, &b, 4); return r; }
__device__ __forceinline__ float lo_bf(unsigned u) { return __uint_as_float(u << 16); }
__device__ __forceinline__ float hi_bf(unsigned u) { return __uint_as_float(u & 0xFFFF0000u); }
__device__ __forceinline__ float silu_f(float x) { return x * __builtin_amdgcn_rcpf(1.0f + __expf(-x)); }
template <int CTRL> __device__ __forceinline__ float dpp_f(float v) {
    return __int_as_float(__builtin_amdgcn_update_dpp(0, __float_as_int(v), CTRL, 0xF, 0xF, true));
}
__device__ __forceinline__ float lane_f(float v, int l) { return __int_as_float(__builtin_amdgcn_readlane(__float_as_int(v), l)); }
__device__ __forceinline__ float wave_sum(float v) {
    v += dpp_f<0xB1>(v);
    v += dpp_f<0x4E>(v);
    v += dpp_f<0x141>(v);
    v += dpp_f<0x140>(v);
    return (lane_f(v, 0) + lane_f(v, 16)) + (lane_f(v, 32) + lane_f(v, 48));
}
__device__ __forceinline__ float wave_max(float v) {
    v = fmaxf(v, dpp_f<0xB1>(v));
    v = fmaxf(v, dpp_f<0x4E>(v));
    v = fmaxf(v, dpp_f<0x141>(v));
    v = fmaxf(v, dpp_f<0x140>(v));
    return fmaxf(fmaxf(lane_f(v, 0), lane_f(v, 16)), fmaxf(lane_f(v, 32), lane_f(v, 48)));
}
__device__ __forceinline__ void swap16(float x, float& a, float& b) { const auto r = __builtin_amdgcn_permlane16_swap(__float_as_uint(x), __float_as_uint(x), false, false); a = __uint_as_float(r[0]); b = __uint_as_float(r[1]); }
__device__ __forceinline__ void swap32(float x, float& a, float& b) { const auto r = __builtin_amdgcn_permlane32_swap(__float_as_uint(x), __float_as_uint(x), false, false); a = __uint_as_float(r[0]); b = __uint_as_float(r[1]); }
__device__ __forceinline__ float xsum_rows(float x) { float a, b; swap16(x, a, b); x = a + b; swap32(x, a, b); return a + b; }
__device__ __forceinline__ float xmax_rows(float x) { float a, b; swap16(x, a, b); x = fmaxf(a, b); swap32(x, a, b); return fmaxf(a, b); }
#define MFMA16(a, b, c) __builtin_amdgcn_mfma_f32_16x16x32_bf16(a, b, c, 0, 0, 0)


#define XB_TMO      128
#define XB_XCNT(j)  (256  + 64 * (j))
#define XB_XSUB(j)  (1280 + 64 * (j))
#define XB_XGEN(j)  (2304 + 64 * (j))
#define XB_TOP      3328
#define XB_TOPGEN   3392
#define XCD_BAR_WORDS 3456
#define XB_SPIN_CAP (1u << 18)
__device__ __forceinline__ unsigned xb_ld(unsigned* p)              { return __hip_atomic_load(p, __ATOMIC_RELAXED, __HIP_MEMORY_SCOPE_AGENT); }
__device__ __forceinline__ unsigned xb_add(unsigned* p, unsigned v) { return __hip_atomic_fetch_add(p, v, __ATOMIC_RELAXED, __HIP_MEMORY_SCOPE_AGENT); }
__device__ __forceinline__ unsigned xb_xcc_id() { return (unsigned)__builtin_amdgcn_s_getreg((3 << 11) | 20) & 0xFu; }
#define XB_SPIN(cond, bar) do { unsigned _sp = 0; while (cond) { __builtin_amdgcn_s_sleep(1); \
    if ((++_sp & 255u) == 0u) { if (xb_ld(&(bar)[XB_TMO])) break; if (_sp > XB_SPIN_CAP) { atomicAdd(&(bar)[XB_TMO], 1u); break; } } } } while (0)
struct XcdBarrier { unsigned* bar; unsigned x; volatile LAS unsigned* st; };
__device__ __forceinline__ XcdBarrier xcd_barrier_post(unsigned* bar, volatile LAS unsigned* st) {
    XcdBarrier b; b.bar = bar; b.x = xb_xcc_id(); b.st = st;
    if (threadIdx.x == 0) (void)xb_add(&bar[XB_XCNT(b.x)], 1u);
    return b;
}
__device__ __forceinline__ void xcd_barrier_complete(unsigned* bar, unsigned x, unsigned& nloc, unsigned& nx) {
    const unsigned G = gridDim.x * gridDim.y * gridDim.z;
    unsigned sum, cnt, mine, sp = 0u;
    for (;;) {
        sum = 0u; cnt = 0u; mine = 0u;
#pragma unroll
        for (unsigned j = 0; j < 16; ++j) { const unsigned c = xb_ld(&bar[XB_XCNT(j)]); sum += c; cnt += (c > 0u) ? 1u : 0u; mine = (j == x) ? c : mine; }
        if (sum == G) break;
        __builtin_amdgcn_s_sleep(1);
        if ((++sp & 255u) == 0u) { if (xb_ld(&bar[XB_TMO])) break; if (sp > XB_SPIN_CAP) { atomicAdd(&bar[XB_TMO], 1u); break; } }
    }
    nloc = mine > 0u ? mine : 1u; nx = cnt > 0u ? cnt : 1u;
}
__device__ __forceinline__ void xcd_barrier(unsigned* bar_, volatile LAS unsigned* st_) {
    XcdBarrier b; b.bar = bar_; b.x = xb_xcc_id(); b.st = st_;
    asm volatile("s_waitcnt vmcnt(0)" ::: "memory");
    __syncthreads();
    if (threadIdx.x == 0) {
        unsigned* bar = b.bar;
        __builtin_amdgcn_s_waitcnt(0);
        unsigned nloc = b.st[0], nx = b.st[1];
        if (nloc == 0u) { xcd_barrier_complete(bar, b.x, nloc, nx); b.st[0] = nloc; b.st[1] = nx; }
        const unsigned old = xb_add(&bar[XB_XSUB(b.x)], 1u);
        const unsigned gen = old / nloc;
        if (old + 1u == (gen + 1u) * nloc) {
            __builtin_amdgcn_fence(__ATOMIC_RELEASE, "agent");
            asm volatile("s_waitcnt vmcnt(0)" ::: "memory");
            const unsigned og = xb_add(&bar[XB_TOP], 1u);
            const unsigned tg = og / nx;
            if (og + 1u == (tg + 1u) * nx) xb_add(&bar[XB_TOPGEN], 1u);
            else XB_SPIN(xb_ld(&bar[XB_TOPGEN]) == tg, bar);
            __builtin_amdgcn_fence(__ATOMIC_ACQUIRE, "agent");
            xb_add(&bar[XB_XGEN(b.x)], 1u);
            asm volatile("s_waitcnt vmcnt(0)" ::: "memory");
        } else {
            XB_SPIN(xb_ld(&bar[XB_XGEN(b.x)]) == gen, bar);
            __builtin_amdgcn_fence(__ATOMIC_ACQUIRE, "agent");
            asm volatile("s_waitcnt vmcnt(0)" ::: "memory");
        }
    }
    __syncthreads();
}

namespace pg8 {
constexpr int BM = 256, BK = 64, HALF = 128, HTB = HALF * BK * 2, NXCD = 8, WGM = 8;
__device__ __forceinline__ int lds_byte(int r, int c) { const int st = (r >> 4) * 2 + (c >> 5), rr = r & 15, cc = c & 31, ob = rr * 64 + cc * 2; return st * 1024 + (ob ^ (((ob >> 9) & 1) << 5)); }
__device__ __forceinline__ void stage_rc(int b, int& R, int& C) { const int st = b / 1024, sb = b % 1024, swz = sb ^ (((sb >> 9) & 1) << 5); R = (st >> 1) * 16 + swz / 64; C = (st & 1) * 32 + (swz % 64) / 2; }
__device__ __forceinline__ int perm32(int rho) { const int n = rho >> 4, i = rho & 15; return 8 * (i >> 2) + 4 * n + (i & 3); }
struct Unit { int pm, pn, koff, nt, mini; };
struct Gemm { const bf16_t* A; const bf16_t* Bt; int M, N, K; };
struct StaticOrder {
    int nM, nN, nwg, G, c, ntm, nextra;
    __device__ void init(int M, int N, int K, int G_, int c_, int nextra_) { nM = M / BM; nN = N / BM; nwg = nM * nN; G = G_; c = c_; ntm = K / BK; nextra = nextra_; }
    __device__ bool next(int i, Unit& u) const {
        const long L = (long)i * G + c;
        if (L >= nwg) {
            const long e = L - nwg; if (e >= nextra) return false;
            u.pm = nM; u.pn = (int)(e % nN); u.koff = (int)(e / nN) * 512; u.nt = 4; u.mini = 1; return true;
        }
        int wgid = (int)L; { const int q = nwg / NXCD, r = nwg % NXCD, xcd = wgid % NXCD, off = wgid / NXCD; wgid = (xcd < r ? xcd * (q + 1) : r * (q + 1) + (xcd - r) * q) + off; }
        const int nig = WGM * nN, gid = wgid / nig, fm = gid * WGM, gsz = (nM - fm) < WGM ? (nM - fm) : WGM;
        u.pm = fm + ((wgid % nig) % gsz); u.pn = (wgid % nig) / gsz; u.koff = 0; u.nt = ntm; u.mini = 0; return true;
    }
};

template <class Epi>
__device__ __forceinline__ void gemm_phase(LAS unsigned char* lds, const Gemm g, const StaticOrder& S, const Epi& E) {
    const int tid = threadIdx.x, wid = __builtin_amdgcn_readfirstlane(tid >> 6), lane = tid & 63, wr = wid >> 2, wc = wid & 3, fr = lane & 15, fq = lane >> 4;
    const int K = g.K;
    unsigned voffA[2], voffB[2];
#pragma unroll
    for (int i = 0; i < 2; ++i) { int R, C; stage_rc(tid * 16 + i * 8192, R, C); const int Rb = (R & ~31) + perm32(R & 31);
        voffA[i] = (unsigned)(R * K + C) * 2u; voffB[i] = (unsigned)(Rb * K + C) * 2u; }
    const size_t kstep = (size_t)(BK * 2);
    const size_t hstep = (size_t)HALF * K * 2;
    const size_t tstep = 2 * hstep;
    const unsigned ldsw = (unsigned)wid * 1024u;
    const int aoff = lds_byte(wr * 64 + fr, fq * 8), boff = lds_byte(wc * 32 + fr, fq * 8);
#define PG8_SA(b, h) (((b) * 2 + (h)) * HTB)
#define PG8_SB(b, h) ((4 + (b) * 2 + (h)) * HTB)
#define PG8_STAGE(bufoff, gbase, voff) do { _Pragma("unroll") for (int _i = 0; _i < 2; ++_i) \
        __builtin_amdgcn_global_load_lds((const unsigned*)((const char*)(gbase) + (voff)[_i]), (LAS unsigned*)(lds + (bufoff) + ldsw + _i * 8192), 16, 0, 0); } while (0)
#define PG8_LDA(dst, b, h) do { _Pragma("unroll") for (int m = 0; m < 4; ++m) _Pragma("unroll") for (int k = 0; k < 2; ++k) dst[m][k] = *(const LAS bf16x8*)(lds + PG8_SA(b, h) + aoff + m * 2048 + k * 1024); } while (0)
#define PG8_LDB(dst, b, h) do { _Pragma("unroll") for (int n = 0; n < 2; ++n) _Pragma("unroll") for (int k = 0; k < 2; ++k) dst[n][k] = *(const LAS bf16x8*)(lds + PG8_SB(b, h) + boff + n * 2048 + k * 1024); } while (0)
#define PG8_MMA(ai, bj, At, Bt) do { __builtin_amdgcn_s_setprio(1); _Pragma("unroll") for (int m = 0; m < 4; ++m) _Pragma("unroll") for (int n = 0; n < 2; ++n) _Pragma("unroll") for (int k = 0; k < 2; ++k) \
        acc[ai][bj][m][n] = __builtin_amdgcn_mfma_f32_16x16x32_bf16(Bt[n][k], At[m][k], acc[ai][bj][m][n], 0, 0, 0); __builtin_amdgcn_s_setprio(0); } while (0)
#define PG8_WAIT_V(n) asm volatile("s_waitcnt vmcnt(" #n ")" ::: "memory")
#define PG8_WAIT_L(n) asm volatile("s_waitcnt lgkmcnt(" #n ")" ::: "memory")
#define PG8_BAR __builtin_amdgcn_s_barrier()
#define PG8_SCHED __builtin_amdgcn_sched_barrier(0)
    Unit cur, nxt; int ui = 0;
    if (!S.next(0, cur)) return;
    f32x4 acc[2][2][4][2];
#pragma unroll
    for (int a = 0; a < 2; ++a)
#pragma unroll
        for (int b = 0; b < 2; ++b)
#pragma unroll
            for (int m = 0; m < 4; ++m)
#pragma unroll
                for (int n = 0; n < 2; ++n) acc[a][b][m][n] = (f32x4){0.f, 0.f, 0.f, 0.f};
    bf16x8 At[4][2], B0[2][2], B1[2][2];
    const char* cA = (const char*)g.A + (size_t)cur.pm * tstep + cur.koff; const char* cB = (const char*)g.Bt + (size_t)cur.pn * tstep + cur.koff;
    PG8_STAGE(PG8_SB(0, 0), cB, voffB); PG8_STAGE(PG8_SA(0, 0), cA, voffA); PG8_STAGE(PG8_SB(0, 1), cB + hstep, voffB); PG8_STAGE(PG8_SA(0, 1), cA + hstep, voffA);
    if (wr == 1) PG8_BAR;
    PG8_WAIT_V(4); PG8_BAR;
    PG8_STAGE(PG8_SB(1, 0), cB + kstep, voffB); PG8_STAGE(PG8_SA(1, 0), cA + kstep, voffA); PG8_STAGE(PG8_SB(1, 1), cB + hstep + kstep, voffB);
    PG8_WAIT_V(6); PG8_BAR;
    for (;;) {
        const bool has_next = S.next(ui + 1, nxt);
        const char* nA = has_next ? (const char*)g.A + (size_t)nxt.pm * tstep + nxt.koff : cA; const char* nB = has_next ? (const char*)g.Bt + (size_t)nxt.pn * tstep + nxt.koff : cB;
        const int nt = cur.nt;
        for (int t = 0; t < nt; t += 2) {
            const bool last = (t == nt - 2);
            const char* a1 = cA + (size_t)(t + 1) * kstep;
            const char* a2 = last ? nA : cA + (size_t)(t + 2) * kstep; const char* b2 = last ? nB : cB + (size_t)(t + 2) * kstep;
            const char* a3 = a2 + kstep; const char* b3 = b2 + kstep;
            PG8_LDB(B0, 0, 0); PG8_SCHED; PG8_LDA(At, 0, 0); PG8_STAGE(PG8_SA(1, 1), a1 + hstep, voffA);
            PG8_WAIT_L(8); PG8_BAR; PG8_WAIT_L(0); PG8_MMA(0, 0, At, B0); PG8_BAR; PG8_SCHED;
            PG8_LDB(B1, 0, 1); PG8_STAGE(PG8_SB(0, 0), b2, voffB);
            PG8_BAR; PG8_WAIT_L(0); PG8_MMA(0, 1, At, B1); PG8_BAR;
            PG8_LDA(At, 0, 1); PG8_STAGE(PG8_SA(0, 0), a2, voffA);
            PG8_BAR; PG8_WAIT_L(0); PG8_MMA(1, 0, At, B0); PG8_BAR; PG8_SCHED;
            PG8_STAGE(PG8_SB(0, 1), b2 + hstep, voffB);
            PG8_WAIT_V(6); PG8_BAR; PG8_MMA(1, 1, At, B1); PG8_BAR;
            PG8_LDB(B0, 1, 0); PG8_SCHED; PG8_LDA(At, 1, 0); PG8_STAGE(PG8_SA(0, 1), a2 + hstep, voffA);
            PG8_WAIT_L(8); PG8_BAR; PG8_WAIT_L(0); PG8_MMA(0, 0, At, B0); PG8_BAR; PG8_SCHED;
            PG8_LDB(B1, 1, 1); PG8_STAGE(PG8_SB(1, 0), b3, voffB);
            PG8_BAR; PG8_WAIT_L(0); PG8_MMA(0, 1, At, B1); PG8_BAR;
            PG8_LDA(At, 1, 1); PG8_STAGE(PG8_SA(1, 0), a3, voffA);
            PG8_BAR; PG8_WAIT_L(0); PG8_MMA(1, 0, At, B0); PG8_BAR; PG8_SCHED;
            PG8_STAGE(PG8_SB(1, 1), b3 + hstep, voffB);
            PG8_WAIT_V(6); PG8_BAR; PG8_MMA(1, 1, At, B1); PG8_BAR;
        }
        E(acc, cur, wr, wc, fr, fq);
        if (!has_next) break;
#pragma unroll
        for (int a = 0; a < 2; ++a)
#pragma unroll
            for (int b = 0; b < 2; ++b)
#pragma unroll
                for (int m = 0; m < 4; ++m)
#pragma unroll
                    for (int n = 0; n < 2; ++n) acc[a][b][m][n] = (f32x4){0.f, 0.f, 0.f, 0.f};
        cur = nxt; cA = nA; cB = nB; ++ui;
    }
    PG8_WAIT_V(0);
    if (wr == 0) PG8_BAR;
    PG8_BAR;
#undef PG8_SA
#undef PG8_SB
#undef PG8_STAGE
#undef PG8_LDA
#undef PG8_LDB
#undef PG8_MMA
#undef PG8_WAIT_V
#undef PG8_WAIT_L
#undef PG8_BAR
#undef PG8_SCHED
}
}

struct EpiIn {
    bf16_t* proj; const float* rstd; const float* lb;
    __device__ __forceinline__ void operator()(const f32x4 (&acc)[2][2][4][2], const pg8::Unit& u, int wr, int wc, int fr, int fq) const {
        const int row0 = u.pm * 256 + wr * 64 + fr;
        const int cl = wc * 32 + 8 * fq;
        float rs[2][4];
#pragma unroll
        for (int ai = 0; ai < 2; ++ai)
#pragma unroll
            for (int m = 0; m < 4; ++m) rs[ai][m] = rstd[row0 + ai * 128 + m * 16];
        const bool is_rf = (u.pn == 5 || u.pn == 6);
        f32x4 lbv[2][2];
        if (is_rf) {
#pragma unroll
            for (int bj = 0; bj < 2; ++bj) { const float* lbp = lb + (u.pn * 2 + bj - 10) * 128 + cl; lbv[bj][0] = *(const f32x4*)lbp; lbv[bj][1] = *(const f32x4*)(lbp + 4); }
        }
#pragma unroll
        for (int bj = 0; bj < 2; ++bj) {
            const int hc = u.pn * 2 + bj;
#pragma unroll
            for (int ai = 0; ai < 2; ++ai)
#pragma unroll
                for (int m = 0; m < 4; ++m) {
                    const int row = row0 + ai * 128 + m * 16;
                    const float rsv = rs[ai][m];
                    float v[8];
#pragma unroll
                    for (int i = 0; i < 8; ++i) v[i] = acc[ai][bj][m][i >> 2][i & 3] * rsv;
                    if (hc < 5) {
                        if (hc < 4) {
#pragma unroll
                            for (int i = 0; i < 8; ++i) v[i] *= 0.18033688011112042f;
                        }
                        if ((wc & 1) == 0) {
                            const double RF[8] = {0.15915494309189535, 0.030863763404701233, 0.005985185712713706, 0.001160663641240061, 0.00022507907903927658, 4.364795279280288e-05, 8.464330808241401e-06, 1.641426262795035e-06};
                            const double pos = row < TP ? (double)(row & (SEQ - 1)) : 16384.0;
#pragma unroll
                            for (int i = 0; i < 8; ++i) {
                                float pa, pb; swap16(v[i], pa, pb);
                                const float o = (fq & 1) ? pa : pb;
                                double rv = pos * RF[i]; rv -= __builtin_floor(rv);
                                const float rf_ = (float)rv;
                                const float c = __builtin_amdgcn_cosf(rf_), sn = __builtin_amdgcn_sinf(rf_);
                                const float r0 = v[i] * c - o * sn, r1 = v[i] * c + o * sn;
                                v[i] = fq == 0 ? r0 : (fq == 1 ? r1 : v[i]);
                            }
                        }
                    } else if ((hc >= 6 && hc < 10) || hc >= 18) {
#pragma unroll
                        for (int i = 0; i < 8; ++i) v[i] = silu_f(v[i]);
                    } else if (hc >= 10 && hc < 14) {
#pragma unroll
                        for (int i = 0; i < 8; ++i) {
                            const float l = lbv[bj][i >> 2][i & 3];
                            const float sg = __builtin_amdgcn_rcpf(1.0f + __expf(-v[i]));
                            v[i] = __logf(l + (1.0f - l) * sg);
                        }
                    }
                    u32x4 w; w.x = cvt_pk_bf16(v[0], v[1]); w.y = cvt_pk_bf16(v[2], v[3]); w.z = cvt_pk_bf16(v[4], v[5]); w.w = cvt_pk_bf16(v[6], v[7]);
                    *(u32x4*)(proj + (size_t)row * INW + hc * 128 + cl) = w;
                }
        }
    }
};
struct EpiSq {
    bf16_t* O; float* ss; float* sb;
    __device__ __forceinline__ void operator()(const f32x4 (&acc)[2][2][4][2], const pg8::Unit& u, int wr, int wc, int fr, int fq) const {
        if (u.mini) {
            const int col0 = u.pn * 256 + wc * 32 + 8 * fq;
            float* slab = sb + (size_t)(u.koff >> 9) * (NS * DM);
#pragma unroll
            for (int m = 0; m < 4; ++m) {
                float* rp = slab + (size_t)(wr * 64 + m * 16 + fr) * DM + col0;
#pragma unroll
                for (int bj = 0; bj < 2; ++bj) { *(f32x4*)(rp + bj * 128) = acc[0][bj][m][0]; *(f32x4*)(rp + bj * 128 + 4) = acc[0][bj][m][1]; }
            }
            return;
        }
        const int row0 = u.pm * 256 + wr * 64 + fr;
        const int col0 = u.pn * 256 + wc * 32 + 8 * fq;
#pragma unroll
        for (int ai = 0; ai < 2; ++ai)
#pragma unroll
            for (int m = 0; m < 4; ++m) {
                const int row = row0 + ai * 128 + m * 16;
                float s = 0.f;
#pragma unroll
                for (int bj = 0; bj < 2; ++bj) {
                    const f32x4 v0 = acc[ai][bj][m][0], v1 = acc[ai][bj][m][1];
                    s += v0[0] * v0[0] + v0[1] * v0[1] + v0[2] * v0[2] + v0[3] * v0[3] + v1[0] * v1[0] + v1[1] * v1[1] + v1[2] * v1[2] + v1[3] * v1[3];
                    u32x4 w; w.x = cvt_pk_bf16(v0[0], v0[1]); w.y = cvt_pk_bf16(v0[2], v0[3]); w.z = cvt_pk_bf16(v1[0], v1[1]); w.w = cvt_pk_bf16(v1[2], v1[3]);
                    *(u32x4*)(O + (size_t)row * DM + col0 + bj * 128) = w;
                }
                s = xsum_rows(s);
                if (fq == 0) ss[(size_t)row * 16 + u.pn * 4 + wc] = s;
            }
    }
};
struct EpiGU {
    bf16_t* act; const float* rstd; float* sb;
    __device__ __forceinline__ void operator()(const f32x4 (&acc)[2][2][4][2], const pg8::Unit& u, int wr, int wc, int fr, int fq) const {
        if (u.mini) {
            const int colt = u.pn * 256 + wc * 32 + 8 * fq;
            float* slab = sb + (size_t)(u.koff >> 9) * (NS * 2 * DFF);
#pragma unroll
            for (int m = 0; m < 4; ++m) {
                float* rp = slab + (size_t)(wr * 64 + m * 16 + fr) * (2 * DFF) + colt;
#pragma unroll
                for (int bj = 0; bj < 2; ++bj) { *(f32x4*)(rp + bj * 128) = acc[0][bj][m][0]; *(f32x4*)(rp + bj * 128 + 4) = acc[0][bj][m][1]; }
            }
            return;
        }
        const int row0 = u.pm * 256 + wr * 64 + fr;
        const int col0 = u.pn * 128 + wc * 32 + 8 * fq;
        float rs[2][4];
#pragma unroll
        for (int ai = 0; ai < 2; ++ai)
#pragma unroll
            for (int m = 0; m < 4; ++m) rs[ai][m] = rstd[row0 + ai * 128 + m * 16];
#pragma unroll
        for (int ai = 0; ai < 2; ++ai)
#pragma unroll
            for (int m = 0; m < 4; ++m) {
                const int row = row0 + ai * 128 + m * 16;
                const float rsv = rs[ai][m];
                float a[8];
#pragma unroll
                for (int i = 0; i < 8; ++i) { const float gv = acc[ai][0][m][i >> 2][i & 3] * rsv, uv = acc[ai][1][m][i >> 2][i & 3] * rsv; a[i] = silu_f(gv) * uv; }
                u32x4 w; w.x = cvt_pk_bf16(a[0], a[1]); w.y = cvt_pk_bf16(a[2], a[3]); w.z = cvt_pk_bf16(a[4], a[5]); w.w = cvt_pk_bf16(a[6], a[7]);
                *(u32x4*)(act + (size_t)row * DFF + col0) = w;
            }
    }
};

struct TileInfo { const float* src; const float* gain; bf16_t* dst; int N, K, k0, n0, drow0; };
__device__ __forceinline__ TileInfo tile_info(const Params& P, int t) {
    const int T_IN = 16 * 44, T_OUT = 16 * 16, T_G = 16 * 44;
    TileInfo ti;
    int i = t;
    if (i < T_IN) { const int kt = i / 44, ntl = i % 44; ti = TileInfo{P.w_in, P.g1, (bf16_t*)(P.ws + WS_WIN), INW, DM, kt * 64, ntl * 64, ntl * 64}; return ti; }
    i -= T_IN;
    if (i < T_OUT) { const int kt = i / 16, ntl = i % 16; ti = TileInfo{P.w_out, nullptr, (bf16_t*)(P.ws + WS_WOUT), DM, DM, kt * 64, ntl * 64, ntl * 64}; return ti; }
    i -= T_OUT;
    if (i < 2 * T_G) { const int up = i >= T_G; if (up) i -= T_G; const int kt = i / 44, ntl = i % 44; const int f0 = ntl * 64;
        ti = TileInfo{up ? P.w_up : P.w_gate, P.g3, (bf16_t*)(P.ws + WS_WGU), DFF, DM, kt * 64, f0, (f0 >> 7) * 256 + (up ? 128 : 0) + (f0 & 127)}; return ti; }
    i -= 2 * T_G;
    { const int kt = i / 16, ntl = i % 16; ti = TileInfo{P.w_down, nullptr, (bf16_t*)(P.ws + WS_WDN), DM, DFF, kt * 64, ntl * 64, ntl * 64}; }
    return ti;
}
__device__ __forceinline__ void tile_load(const TileInfo& ti, int kr, int c4, f32x4& v0, f32x4& v1) {
    const float* p0 = ti.src + (size_t)(ti.k0 + kr) * ti.N + ti.n0 + c4 * 4;
    v0 = *(const f32x4*)p0; v1 = *(const f32x4*)(p0 + (size_t)32 * ti.N);
    if (ti.gain) { const float g0 = ti.gain[ti.k0 + kr], g1 = ti.gain[ti.k0 + kr + 32]; v0 *= g0; v1 *= g1; }
}

__device__ __forceinline__ void prep_weights(const Params& P, unsigned char* lds, int t0, int t1, int j, int stride) {
    const int tid = threadIdx.x;
    float* tile = (float*)lds;
    const int kr = tid >> 4, c4 = tid & 15, n = tid >> 3, kg = tid & 7;
    int t = t0 + j;
    f32x4 v0, v1; TileInfo cur;
    if (t < t1) { cur = tile_info(P, t); tile_load(cur, kr, c4, v0, v1); }
    for (; t < t1; t += stride) {
        __syncthreads();
        *(f32x4*)(tile + kr * 68 + c4 * 4) = v0; *(f32x4*)(tile + (kr + 32) * 68 + c4 * 4) = v1;
        const TileInfo me = cur;
        if (t + stride < t1) { cur = tile_info(P, t + stride); tile_load(cur, kr, c4, v0, v1); }
        __syncthreads();
        float x[8];
#pragma unroll
        for (int jj = 0; jj < 8; ++jj) x[jj] = tile[(kg * 8 + jj) * 68 + n];
        u32x4 o; o.x = cvt_pk_bf16(x[0], x[1]); o.y = cvt_pk_bf16(x[2], x[3]); o.z = cvt_pk_bf16(x[4], x[5]); o.w = cvt_pk_bf16(x[6], x[7]);
        *(u32x4*)(me.dst + (size_t)(me.drow0 + n) * me.K + me.k0 + kg * 8) = o;
    }
}

__device__ __forceinline__ void phase_prep(const Params& P, unsigned char* lds) {
    const int tid = threadIdx.x, w = __builtin_amdgcn_readfirstlane(tid >> 6), lane = tid & 63;
    {
        bf16_t* xb = (bf16_t*)(P.ws + WS_XB); float* rstd1 = (float*)(P.ws + WS_RSTD1);
        const int NW = gridDim.x * 8;
        for (int rowa = blockIdx.x * 8 + w; rowa < MP; rowa += 4 * NW) {
            f32x4 v[4][4];
#pragma unroll
            for (int r = 0; r < 4; ++r) {
                const int row = rowa + r * NW;
                const float* src = row < TP ? P.xp + (size_t)row * DM : (row < TP + NS ? P.xs + (size_t)(row - TP) * DM : nullptr);
#pragma unroll
                for (int i = 0; i < 4; ++i) { v[r][i] = (f32x4){0.f, 0.f, 0.f, 0.f}; if (src) v[r][i] = __builtin_nontemporal_load((const f32x4*)(src + i * 256 + lane * 4)); }
            }
#pragma unroll
            for (int r = 0; r < 4; ++r) {
                const int row = rowa + r * NW;
                if (row < MP) {
                    float ss = 0.f;
#pragma unroll
                    for (int i = 0; i < 4; ++i) {
                        const f32x4 x = v[r][i];
                        ss += x[0] * x[0] + x[1] * x[1] + x[2] * x[2] + x[3] * x[3];
                        u32x2 o; o.x = cvt_pk_bf16(x[0], x[1]); o.y = cvt_pk_bf16(x[2], x[3]);
                        *(u32x2*)(xb + (size_t)row * DM + i * 256 + lane * 4) = o;
                    }
                    ss = wave_sum(ss);
                    if (lane == 0) rstd1[row] = rsqrtf(ss * (1.0f / DM) + EPS);
                }
            }
        }
    }
    prep_weights(P, lds, 0, 16 * 44, blockIdx.x, gridDim.x);
    if (blockIdx.x == 0) {
        float* lb = (float*)(P.ws + WS_LB);
        const float a = P.rec_lb[tid], b = P.rec_lb[512 + tid];
        lb[tid] = 1.0f / (1.0f + expf(b - a));
    }
}

__device__ __forceinline__ void attn_prompt_item(const Params& P, unsigned char* lds, int item) {
    const int tid = threadIdx.x, w = __builtin_amdgcn_readfirstlane(tid >> 6), lane = tid & 63, fr = lane & 15, fq = lane >> 4;
    const int hkv = item & 1, nb = (item >> 1) & 63, b = item >> 7;
    bf16_t* Ks = (bf16_t*)lds;
    bf16_t* Vt = (bf16_t*)(lds + 36864);
    const bf16_t* proj = (const bf16_t*)(P.ws + WS_PROJ);
    bf16_t* mix = (bf16_t*)(P.ws + WS_MIX);
    const int h = hkv * 4 + (w >> 1);
    const bf16_t* qbase = proj + ((size_t)b * SEQ + nb * 128 + (w & 1) * 64 + fr) * INW + h * 64 + fq * 8;
    bf16x8 nq0 = *(const bf16x8*)qbase, nq1 = *(const bf16x8*)(qbase + 32);
    __syncthreads();
    {
        u32x4 kvs[4], vvs[4];
#pragma unroll
        for (int u = 0; u < 4; ++u) {
            const int c = tid + u * 512, r = c >> 3, ch = c & 7;
            kvs[u] = (u32x4){0u, 0u, 0u, 0u}; vvs[u] = (u32x4){0u, 0u, 0u, 0u};
            if (nb > 0 || r >= 128) {
                const size_t row = (size_t)b * SEQ + (size_t)((nb - 1) * 128 + r);
                const bf16_t* pr = proj + row * INW + 512 + hkv * 64 + ch * 8;
                kvs[u] = *(const u32x4*)pr; vvs[u] = *(const u32x4*)(pr + 128);
            }
        }
#pragma unroll
        for (int u = 0; u < 4; ++u) {
            const int c = tid + u * 512, r = c >> 3, ch = c & 7;
            const u32x4 kv = kvs[u], vv = vvs[u];
            *(u32x4*)(Ks + r * 72 + ch * 8) = kv;
#pragma unroll
            for (int i = 0; i < 8; ++i) Vt[(ch * 8 + i) * 264 + r] = (bf16_t)(vv[i >> 1] >> ((i & 1) * 16));
            if (nb == 63 && r >= 128) {
                const size_t o = ((size_t)(b * 128 + (r - 128)) * 2 + hkv) * 64 + ch * 8;
                float* ok = P.out + OUT_KP + o; float* ov = P.out + OUT_VP + o;
                *(f32x4*)ok = (f32x4){lo_bf(kv[0]), hi_bf(kv[0]), lo_bf(kv[1]), hi_bf(kv[1])}; *(f32x4*)(ok + 4) = (f32x4){lo_bf(kv[2]), hi_bf(kv[2]), lo_bf(kv[3]), hi_bf(kv[3])};
                *(f32x4*)ov = (f32x4){lo_bf(vv[0]), hi_bf(vv[0]), lo_bf(vv[1]), hi_bf(vv[1])}; *(f32x4*)(ov + 4) = (f32x4){lo_bf(vv[2]), hi_bf(vv[2]), lo_bf(vv[3]), hi_bf(vv[3])};
            }
        }
    }
    __syncthreads();
    const float sink2 = P.sinks[h] * 1.4426950408889634f;
    for (int it = 0; it < 4; ++it) {
        const int qi0 = (w & 1) * 64 + it * 16, kt0 = qi0 >> 4;
        const bf16x8 bq0 = nq0, bq1 = nq1;
        if (it < 3) { const bf16_t* qp = qbase + (size_t)(it + 1) * 16 * INW; nq0 = *(const bf16x8*)qp; nq1 = *(const bf16x8*)(qp + 32); }
        f32x4 s[9];
#pragma unroll
        for (int j = 0; j < 9; ++j) {
            const bf16_t* kp = Ks + ((kt0 + j) * 16 + fr) * 72 + fq * 8;
            f32x4 a = {0.f, 0.f, 0.f, 0.f};
            a = MFMA16(*(const bf16x8*)kp, bq0, a);
            a = MFMA16(*(const bf16x8*)(kp + 32), bq1, a);
            s[j] = a;
        }
        float m = sink2;
        if (nb > 0) {
#pragma unroll
            for (int e = 0; e < 4; ++e) {
                s[0][e] = (fq * 4 + e > fr) ? s[0][e] : -1e30f;
                s[8][e] = (fq * 4 + e <= fr) ? s[8][e] : -1e30f;
            }
        } else {
            const int qi = qi0 + fr;
#pragma unroll
            for (int j = 0; j < 9; ++j)
#pragma unroll
                for (int e = 0; e < 4; ++e) {
                    const int ki = (kt0 + j) * 16 + fq * 4 + e;
                    const bool valid = (ki > qi) && (ki <= qi + 128) && (ki >= 128);
                    s[j][e] = valid ? s[j][e] : -1e30f;
                }
        }
#pragma unroll
        for (int j = 0; j < 9; ++j)
#pragma unroll
            for (int e = 0; e < 4; ++e) m = fmaxf(m, s[j][e]);
        m = xmax_rows(m);
        float sum = 0.f;
#pragma unroll
        for (int j = 0; j < 9; ++j)
#pragma unroll
            for (int e = 0; e < 4; ++e) { const float p = __builtin_amdgcn_exp2f(s[j][e] - m); s[j][e] = p; sum += p; }
        sum = xsum_rows(sum);
        const float inv = 1.0f / (sum + __builtin_amdgcn_exp2f(sink2 - m));
        f32x4 o[4];
#pragma unroll
        for (int dt = 0; dt < 4; ++dt) o[dt] = (f32x4){0.f, 0.f, 0.f, 0.f};
#pragma unroll
        for (int kk = 0; kk < 5; ++kk) {
            const int j0 = 2 * kk, j1 = 2 * kk + 1, j1c = j1 < 9 ? j1 : 8;
            u32x4 pa;
            pa.x = cvt_pk_bf16(s[j0][0], s[j0][1]); pa.y = cvt_pk_bf16(s[j0][2], s[j0][3]);
            if (j1 < 9) { pa.z = cvt_pk_bf16(s[j1c][0], s[j1c][1]); pa.w = cvt_pk_bf16(s[j1c][2], s[j1c][3]); } else { pa.z = 0u; pa.w = 0u; }
            bf16x8 aop; __builtin_memcpy(&aop, &pa, 16);
#pragma unroll
            for (int dt = 0; dt < 4; ++dt) {
                const bf16_t* vp = Vt + (dt * 16 + fr) * 264 + fq * 4;
                u32x2 v0 = *(const u32x2*)(vp + (kt0 + j0) * 16), v1 = *(const u32x2*)(vp + (kt0 + j1c) * 16);
                u32x4 vb; vb.x = v0.x; vb.y = v0.y; vb.z = v1.x; vb.w = v1.y;
                bf16x8 bop; __builtin_memcpy(&bop, &vb, 16);
                o[dt] = MFMA16(bop, aop, o[dt]);
            }
        }
#pragma unroll
        for (int dt = 0; dt < 4; ++dt) {
            u32x2 ow; ow.x = cvt_pk_bf16(o[dt][0] * inv, o[dt][1] * inv); ow.y = cvt_pk_bf16(o[dt][2] * inv, o[dt][3] * inv);
            *(u32x2*)(mix + ((size_t)b * SEQ + nb * 128 + qi0 + fr) * DM + h * 64 + dt * 16 + fq * 4) = ow;
        }
    }
}

__device__ __forceinline__ void dec_attn_item(const Params& P, unsigned char* lds, int item) {
    const int tid = threadIdx.x, w = __builtin_amdgcn_readfirstlane(tid >> 6), lane = tid & 63;
    const int hkv = item & 1, b = item >> 1;
    float* Kl = (float*)lds;
    float* Vl = (float*)(lds + 33280);
    float* Pb = (float*)(lds + 66048);
    float* Qs = (float*)(lds + 66048 + 2048);
    const bf16_t* pr = (const bf16_t*)(P.ws + WS_PROJ) + (size_t)(TP + b) * INW;
    bf16_t* mix = (bf16_t*)(P.ws + WS_MIX);
    const float* ck = P.ck + (size_t)b * 16384 + hkv * 64; const float* cv = P.cv + (size_t)b * 16384 + hkv * 64;
    float* ok = P.out + OUT_KS + (size_t)b * 16384 + hkv * 64; float* ov = P.out + OUT_VS + (size_t)b * 16384 + hkv * 64;
    __syncthreads();
    {
        float kr[16], vr[16];
#pragma unroll
        for (int u = 0; u < 16; ++u) {
            const int idx = tid + u * 512, r = idx >> 6, c = idx & 63;
            if (r < 127) { kr[u] = ck[(r + 1) * 128 + c]; vr[u] = cv[(r + 1) * 128 + c]; } else { kr[u] = bf2f(pr[512 + hkv * 64 + c]); vr[u] = bf2f(pr[640 + hkv * 64 + c]); }
        }
#pragma unroll
        for (int u = 0; u < 16; ++u) {
            const int idx = tid + u * 512, r = idx >> 6, c = idx & 63;
            Kl[r * 65 + c] = kr[u]; Vl[r * 64 + c] = vr[u]; ok[r * 128 + c] = kr[u]; ov[r * 128 + c] = vr[u];
        }
    }
    const int h = hkv * 4 + (w & 3);
    if (w < 4) Qs[w * 64 + lane] = bf2f(pr[h * 64 + lane]);
    __syncthreads();
    float sum = 1.f;
    if (w < 4) {
        const float sink = P.sinks[h] * 1.4426950408889634f;
        float s0 = 0.f, s1 = 0.f;
#pragma unroll 8
        for (int d = 0; d < 64; ++d) { const float q = Qs[w * 64 + d]; s0 += q * Kl[lane * 65 + d]; s1 += q * Kl[(lane + 64) * 65 + d]; }
        const float m = fmaxf(sink, wave_max(fmaxf(s0, s1)));
        const float p0 = __builtin_amdgcn_exp2f(s0 - m), p1 = __builtin_amdgcn_exp2f(s1 - m);
        sum = wave_sum(p0 + p1) + __builtin_amdgcn_exp2f(sink - m);
        Pb[w * 128 + lane] = p0; Pb[w * 128 + 64 + lane] = p1;
    }
    __syncthreads();
    if (w < 4) {
        float o = 0.f;
#pragma unroll 8
        for (int key = 0; key < 128; ++key) o += Pb[w * 128 + key] * Vl[key * 64 + lane];
        mix[(size_t)(TP + b) * DM + h * 64 + lane] = f2bf(o / sum);
    }
}

__device__ __forceinline__ void dec_hgrn_item(const Params& P, unsigned char* lds, int item) {
    const int tid = threadIdx.x, w = __builtin_amdgcn_readfirstlane(tid >> 6), lane = tid & 63;
    const int h = item & 3, b = item >> 2;
    float* red = (float*)lds;
    float* ssb = (float*)(lds + 8192);
    const bf16_t* pr = (const bf16_t*)(P.ws + WS_PROJ) + (size_t)(TP + b) * INW;
    bf16_t* mix = (bf16_t*)(P.ws + WS_MIX);
    __syncthreads();
    const int v4 = tid & 31, kg = tid >> 5;
    f32x4 iv;
#pragma unroll
    for (int j = 0; j < 4; ++j) iv[j] = bf2f(pr[1792 + h * 128 + v4 * 4 + j]);
    const float* S0 = P.st + (size_t)(b * 4 + h) * 16384; float* So = P.out + OUT_SS + (size_t)(b * 4 + h) * 16384;
    f32x4 oacc = {0.f, 0.f, 0.f, 0.f};
    f32x4 sv[8]; float fv[8], qv[8];
#pragma unroll
    for (int kk = 0; kk < 8; ++kk) {
        const int dk = kg * 8 + kk;
        sv[kk] = *(const f32x4*)(S0 + dk * 128 + v4 * 4);
        fv[kk] = bf2f(pr[1280 + h * 128 + dk]); qv[kk] = bf2f(pr[768 + h * 128 + dk]);
    }
#pragma unroll
    for (int kk = 0; kk < 8; ++kk) {
        const int dk = kg * 8 + kk;
        const float f = __expf(fv[kk]), kq = 1.0f - f;
        const f32x4 sn = sv[kk] * f + iv * kq;
        *(f32x4*)(So + dk * 128 + v4 * 4) = sn;
        oacc += sn * qv[kk];
    }
    *(f32x4*)(red + kg * 128 + v4 * 4) = oacc;
    __syncthreads();
    float o = 0.f;
    if (tid < 128) {
#pragma unroll
        for (int g = 0; g < 16; ++g) o += red[g * 128 + tid];
        const float part = wave_sum(o * o);
        if (lane == 0) ssb[w] = part;
    }
    __syncthreads();
    if (tid < 128) {
        const float r = rsqrtf((ssb[0] + ssb[1]) * (1.0f / 128.0f) + EPS);
        const float g = bf2f(pr[2304 + h * 128 + tid]);
        mix[(size_t)(TP + b) * DM + 512 + h * 128 + tid] = f2bf(o * r * P.rec_norm[h * 128 + tid] * g);
    }
}

template <bool OUT>
__device__ __forceinline__ void hgrn_item(const Params& P, unsigned char* lds, int item) {
    const int tid = threadIdx.x, w = __builtin_amdgcn_readfirstlane(tid >> 6), lane = tid & 63, fr = lane & 15, fq = lane >> 4;
    const int sc = item & 31, s = item >> 5, h = s & 3, b = s >> 2;
    bf16_t* Qs = (bf16_t*)(lds);
    bf16_t* Qp = (bf16_t*)(lds + 8704);
    bf16_t* Kp = (bf16_t*)(lds + 17408);
    bf16_t* Kt = (bf16_t*)(lds + 26112);
    bf16_t* It = (bf16_t*)(lds + 36352);
    bf16_t* Am = (bf16_t*)(lds + 46592);
    float* dl = (float*)(lds + 49152);
    float* tot = (float*)(lds + 49664);
    float* Ob = (float*)(lds + 53760);
    const bf16_t* proj = (const bf16_t*)(P.ws + WS_PROJ);
    bf16_t* mix = (bf16_t*)(P.ws + WS_MIX);
    float* HU = (float*)(P.ws + WS_HU) + (size_t)item * 16384;
    float* HD = (float*)(P.ws + WS_HD) + (size_t)item * 128;
    __syncthreads();
    f32x4 S[8];
#pragma unroll
    for (int m = 0; m < 8; ++m)
#pragma unroll
        for (int e = 0; e < 4; ++e) S[m][e] = OUT ? HU[(m * 16 + fq * 4 + e) * 128 + w * 16 + fr] : 0.f;
    const int cp = tid & 63, tg = w, c0 = 2 * cp;
    float dtot0 = 0.f, dtot1 = 0.f;
    const float rn0 = OUT ? P.rec_norm[h * 128 + c0] : 0.f, rn1 = OUT ? P.rec_norm[h * 128 + c0 + 1] : 0.f;
    unsigned nlw[4], nqw[4], niw[4], ngw[4];
    {
        const size_t row0 = (size_t)b * SEQ + sc * 256;
#pragma unroll
        for (int tt = 0; tt < 4; ++tt) {
            const bf16_t* rp = proj + (row0 + tg * 4 + tt) * INW + h * 128 + c0;
            nlw[tt] = *(const unsigned*)(rp + 1280); niw[tt] = *(const unsigned*)(rp + 1792);
            if (OUT) { nqw[tt] = *(const unsigned*)(rp + 768); ngw[tt] = *(const unsigned*)(rp + 2304); }
        }
    }
    for (int sub = 0; sub < 8; ++sub) {
        const size_t row0 = (size_t)b * SEQ + sc * 256 + sub * 32;
        float l0[4], l1[4], q0[4], q1[4]; unsigned iw[4], gw[4];
#pragma unroll
        for (int tt = 0; tt < 4; ++tt) {
            l0[tt] = lo_bf(nlw[tt]) * 1.4426950408889634f; l1[tt] = hi_bf(nlw[tt]) * 1.4426950408889634f; iw[tt] = niw[tt];
            if (OUT) { q0[tt] = lo_bf(nqw[tt]); q1[tt] = hi_bf(nqw[tt]); gw[tt] = ngw[tt]; }
        }
        if (sub < 7) {
#pragma unroll
            for (int tt = 0; tt < 4; ++tt) {
                const bf16_t* rp = proj + (row0 + 32 + tg * 4 + tt) * INW + h * 128 + c0;
                nlw[tt] = *(const unsigned*)(rp + 1280); niw[tt] = *(const unsigned*)(rp + 1792);
                if (OUT) { nqw[tt] = *(const unsigned*)(rp + 768); ngw[tt] = *(const unsigned*)(rp + 2304); }
            }
        }
        float c0s[4], c1s[4];
        c0s[0] = l0[0]; c1s[0] = l1[0];
#pragma unroll
        for (int tt = 1; tt < 4; ++tt) { c0s[tt] = c0s[tt - 1] + l0[tt]; c1s[tt] = c1s[tt - 1] + l1[tt]; }
        tot[tg * 128 + c0] = c0s[3]; tot[tg * 128 + c0 + 1] = c1s[3];
        __syncthreads();
        float base0 = 0.f, base1 = 0.f, ref0 = 0.f, ref1 = 0.f, last0 = 0.f, last1 = 0.f;
#pragma unroll
        for (int g = 0; g < 8; ++g) {
            const float t0 = tot[g * 128 + c0], t1 = tot[g * 128 + c0 + 1];
            if (g < tg) { base0 += t0; base1 += t1; }
            if (g < 4) { ref0 += t0; ref1 += t1; }
            last0 += t0; last1 += t1;
        }
        float kt0[4], kt1[4];
#pragma unroll
        for (int tt = 0; tt < 4; ++tt) {
            const int t = tg * 4 + tt;
            const float b0 = base0 + c0s[tt], b1 = base1 + c1s[tt];
            const float k0 = 1.0f - __builtin_amdgcn_exp2f(l0[tt]), k1 = 1.0f - __builtin_amdgcn_exp2f(l1[tt]);
            kt0[tt] = k0 * __builtin_amdgcn_exp2f(last0 - b0); kt1[tt] = k1 * __builtin_amdgcn_exp2f(last1 - b1);
            if (OUT) {
                *(unsigned*)(Qs + t * 136 + c0) = cvt_pk_bf16(q0[tt] * __builtin_amdgcn_exp2f(b0), q1[tt] * __builtin_amdgcn_exp2f(b1));
                const float e0 = fminf(fmaxf(b0 - ref0, -115.f), 115.f), e1 = fminf(fmaxf(b1 - ref1, -115.f), 115.f);
                *(unsigned*)(Qp + t * 136 + c0) = cvt_pk_bf16(q0[tt] * __builtin_amdgcn_exp2f(e0), q1[tt] * __builtin_amdgcn_exp2f(e1));
                *(unsigned*)(Kp + t * 136 + c0) = cvt_pk_bf16(k0 * __builtin_amdgcn_exp2f(-e0), k1 * __builtin_amdgcn_exp2f(-e1));
            }
        }
        {
            u32x2 kw0, kw1, iw0, iw1;
            kw0.x = cvt_pk_bf16(kt0[0], kt0[1]); kw0.y = cvt_pk_bf16(kt0[2], kt0[3]); kw1.x = cvt_pk_bf16(kt1[0], kt1[1]); kw1.y = cvt_pk_bf16(kt1[2], kt1[3]);
            iw0.x = (iw[0] & 0xFFFFu) | (iw[1] << 16); iw0.y = (iw[2] & 0xFFFFu) | (iw[3] << 16);
            iw1.x = (iw[0] >> 16) | (iw[1] & 0xFFFF0000u); iw1.y = (iw[2] >> 16) | (iw[3] & 0xFFFF0000u);
            *(u32x2*)(Kt + c0 * 40 + tg * 4) = kw0; *(u32x2*)(Kt + (c0 + 1) * 40 + tg * 4) = kw1;
            *(u32x2*)(It + c0 * 40 + tg * 4) = iw0; *(u32x2*)(It + (c0 + 1) * 40 + tg * 4) = iw1;
        }
        if (tg == 0) { dl[c0] = __builtin_amdgcn_exp2f(last0); dl[c0 + 1] = __builtin_amdgcn_exp2f(last1); dtot0 += last0; dtot1 += last1; }
        __syncthreads();
        f32x4 o[2];
        if (OUT) {
            o[0] = (f32x4){0.f, 0.f, 0.f, 0.f}; o[1] = (f32x4){0.f, 0.f, 0.f, 0.f};
#pragma unroll
            for (int kk = 0; kk < 4; ++kk) {
                const int m0 = 2 * kk, m1 = 2 * kk + 1;
                u32x4 sb; sb.x = cvt_pk_bf16(S[m0][0], S[m0][1]); sb.y = cvt_pk_bf16(S[m0][2], S[m0][3]); sb.z = cvt_pk_bf16(S[m1][0], S[m1][1]); sb.w = cvt_pk_bf16(S[m1][2], S[m1][3]);
                bf16x8 bop; __builtin_memcpy(&bop, &sb, 16);
#pragma unroll
                for (int mt = 0; mt < 2; ++mt) {
                    const bf16_t* ap = Qs + (mt * 16 + fr) * 136 + fq * 4;
                    const u32x2 a0 = *(const u32x2*)(ap + m0 * 16), a1 = *(const u32x2*)(ap + m1 * 16);
                    u32x4 av; av.x = a0.x; av.y = a0.y; av.z = a1.x; av.w = a1.y;
                    bf16x8 aop; __builtin_memcpy(&aop, &av, 16);
                    o[mt] = MFMA16(aop, bop, o[mt]);
                }
            }
            if (w < 3) {
                const int mt = w > 0 ? 1 : 0, nt = w > 1 ? 1 : 0;
                f32x4 a = {0.f, 0.f, 0.f, 0.f};
#pragma unroll
                for (int ks = 0; ks < 4; ++ks) {
                    const bf16x8 aop = *(const bf16x8*)(Qp + (mt * 16 + fr) * 136 + ks * 32 + fq * 8);
                    const bf16x8 bop = *(const bf16x8*)(Kp + (nt * 16 + fr) * 136 + ks * 32 + fq * 8);
                    a = MFMA16(aop, bop, a);
                }
#pragma unroll
                for (int e = 0; e < 4; ++e) {
                    const int t = mt * 16 + fq * 4 + e, sx = nt * 16 + fr;
                    Am[t * 40 + sx] = (sx <= t) ? f2bf(a[e]) : (bf16_t)0;
                }
            } else if (w == 3) {
#pragma unroll
                for (int e = 0; e < 4; ++e) Am[(fq * 4 + e) * 40 + 16 + fr] = (bf16_t)0;
            }
            __syncthreads();
        }
        const bf16x8 bi = *(const bf16x8*)(It + (w * 16 + fr) * 40 + fq * 8);
        if (OUT) {
#pragma unroll
            for (int mt = 0; mt < 2; ++mt) {
                const bf16x8 aop = *(const bf16x8*)(Am + (mt * 16 + fr) * 40 + fq * 8);
                o[mt] = MFMA16(aop, bi, o[mt]);
            }
        }
#pragma unroll
        for (int m = 0; m < 8; ++m) {
            const f32x4 dv = *(const f32x4*)(dl + m * 16 + fq * 4);
            S[m] = S[m] * dv;
            const bf16x8 aop = *(const bf16x8*)(Kt + (m * 16 + fr) * 40 + fq * 8);
            S[m] = MFMA16(aop, bi, S[m]);
        }
        if (OUT) {
#pragma unroll
            for (int mt = 0; mt < 2; ++mt)
#pragma unroll
                for (int e = 0; e < 4; ++e) Ob[(mt * 16 + fq * 4 + e) * 132 + w * 16 + fr] = o[mt][e];
            __syncthreads();
#pragma unroll
            for (int tt = 0; tt < 4; ++tt) {
                const int t = w * 4 + tt;
                const float v0 = Ob[t * 132 + 2 * lane], v1 = Ob[t * 132 + 2 * lane + 1];
                const float ssq = wave_sum(v0 * v0 + v1 * v1);
                const float r = rsqrtf(ssq * (1.0f / 128.0f) + EPS);
                *(unsigned*)(mix + (row0 + t) * DM + 512 + h * 128 + 2 * lane) = cvt_pk_bf16(v0 * r * rn0 * lo_bf(gw[tt]), v1 * r * rn1 * hi_bf(gw[tt]));
            }
        }
    }
    if (!OUT) {
#pragma unroll
        for (int m = 0; m < 8; ++m)
#pragma unroll
            for (int e = 0; e < 4; ++e) HU[(m * 16 + fq * 4 + e) * 128 + w * 16 + fr] = S[m][e];
        if (tg == 0) { HD[c0] = __builtin_amdgcn_exp2f(dtot0); HD[c0 + 1] = __builtin_amdgcn_exp2f(dtot1); }
    }
}

__device__ __forceinline__ void hgrn_state_item(const Params& P, unsigned char* lds, int item) {
    const int tid = threadIdx.x, w = __builtin_amdgcn_readfirstlane(tid >> 6), lane = tid & 63, fr = lane & 15, fq = lane >> 4;
    const int sc = item & 31, s = item >> 5, h = s & 3, b = s >> 2;
    bf16_t* Kt = (bf16_t*)(lds);
    bf16_t* It = (bf16_t*)(lds + 34816);
    float* dl = (float*)(lds + 69632);
    float* tot = (float*)(lds + 70144);
    const bf16_t* proj = (const bf16_t*)(P.ws + WS_PROJ);
    float* HU = (float*)(P.ws + WS_HU) + (size_t)item * 16384;
    float* HD = (float*)(P.ws + WS_HD) + (size_t)item * 128;
    const int c0 = 2 * lane, tg = w;
    f32x4 S[8];
#pragma unroll
    for (int m = 0; m < 8; ++m) S[m] = (f32x4){0.f, 0.f, 0.f, 0.f};
    float dtot0 = 0.f, dtot1 = 0.f;
    __syncthreads();
    for (int step = 0; step < 2; ++step) {
        const size_t row0 = (size_t)b * SEQ + sc * 256 + step * 128 + tg * 16;
        unsigned lw[16], iw[16];
#pragma unroll
        for (int tt = 0; tt < 16; ++tt) {
            const bf16_t* rp = proj + (row0 + tt) * INW + h * 128 + c0;
            lw[tt] = *(const unsigned*)(rp + 1280); iw[tt] = *(const unsigned*)(rp + 1792);
        }
        float c0s[16], c1s[16];
        float la[16], lb2[16];
#pragma unroll
        for (int tt = 0; tt < 16; ++tt) { la[tt] = lo_bf(lw[tt]) * 1.4426950408889634f; lb2[tt] = hi_bf(lw[tt]) * 1.4426950408889634f; }
        c0s[0] = la[0]; c1s[0] = lb2[0];
#pragma unroll
        for (int tt = 1; tt < 16; ++tt) { c0s[tt] = c0s[tt - 1] + la[tt]; c1s[tt] = c1s[tt - 1] + lb2[tt]; }
        tot[tg * 128 + c0] = c0s[15]; tot[tg * 128 + c0 + 1] = c1s[15];
        __syncthreads();
        float base0 = 0.f, base1 = 0.f, last0 = 0.f, last1 = 0.f;
#pragma unroll
        for (int g = 0; g < 8; ++g) {
            const float t0 = tot[g * 128 + c0], t1 = tot[g * 128 + c0 + 1];
            if (g < tg) { base0 += t0; base1 += t1; }
            last0 += t0; last1 += t1;
        }
        unsigned kw0[8], kw1[8], iw0[8], iw1[8];
#pragma unroll
        for (int t2 = 0; t2 < 8; ++t2) {
            float ka[2], kb[2];
#pragma unroll
            for (int u = 0; u < 2; ++u) {
                const int tt = 2 * t2 + u;
                const float b0 = base0 + c0s[tt], b1 = base1 + c1s[tt];
                ka[u] = (1.0f - __builtin_amdgcn_exp2f(la[tt])) * __builtin_amdgcn_exp2f(last0 - b0);
                kb[u] = (1.0f - __builtin_amdgcn_exp2f(lb2[tt])) * __builtin_amdgcn_exp2f(last1 - b1);
            }
            kw0[t2] = cvt_pk_bf16(ka[0], ka[1]); kw1[t2] = cvt_pk_bf16(kb[0], kb[1]);
            iw0[t2] = (iw[2 * t2] & 0xFFFFu) | (iw[2 * t2 + 1] << 16);
            iw1[t2] = (iw[2 * t2] >> 16) | (iw[2 * t2 + 1] & 0xFFFF0000u);
        }
#pragma unroll
        for (int q = 0; q < 2; ++q) {
            u32x4 a, bq, c, d;
            a.x = kw0[4 * q]; a.y = kw0[4 * q + 1]; a.z = kw0[4 * q + 2]; a.w = kw0[4 * q + 3];
            bq.x = kw1[4 * q]; bq.y = kw1[4 * q + 1]; bq.z = kw1[4 * q + 2]; bq.w = kw1[4 * q + 3];
            c.x = iw0[4 * q]; c.y = iw0[4 * q + 1]; c.z = iw0[4 * q + 2]; c.w = iw0[4 * q + 3];
            d.x = iw1[4 * q]; d.y = iw1[4 * q + 1]; d.z = iw1[4 * q + 2]; d.w = iw1[4 * q + 3];
            *(u32x4*)(Kt + c0 * 136 + tg * 16 + q * 8) = a; *(u32x4*)(Kt + (c0 + 1) * 136 + tg * 16 + q * 8) = bq;
            *(u32x4*)(It + c0 * 136 + tg * 16 + q * 8) = c; *(u32x4*)(It + (c0 + 1) * 136 + tg * 16 + q * 8) = d;
        }
        if (tg == 0) { dl[c0] = __builtin_amdgcn_exp2f(last0); dl[c0 + 1] = __builtin_amdgcn_exp2f(last1); dtot0 += last0; dtot1 += last1; }
        __syncthreads();
        bf16x8 bi[4];
#pragma unroll
        for (int ks = 0; ks < 4; ++ks) bi[ks] = *(const bf16x8*)(It + (w * 16 + fr) * 136 + ks * 32 + fq * 8);
#pragma unroll
        for (int m = 0; m < 8; ++m) {
            const f32x4 dv = *(const f32x4*)(dl + m * 16 + fq * 4);
            S[m] = S[m] * dv;
#pragma unroll
            for (int ks = 0; ks < 4; ++ks) {
                const bf16x8 aop = *(const bf16x8*)(Kt + (m * 16 + fr) * 136 + ks * 32 + fq * 8);
                S[m] = MFMA16(aop, bi[ks], S[m]);
            }
        }
    }
#pragma unroll
    for (int m = 0; m < 8; ++m)
#pragma unroll
        for (int e = 0; e < 4; ++e) HU[(m * 16 + fq * 4 + e) * 128 + w * 16 + fr] = S[m][e];
    if (tg == 0) { HD[c0] = __builtin_amdgcn_exp2f(dtot0); HD[c0 + 1] = __builtin_amdgcn_exp2f(dtot1); }
}

__device__ __forceinline__ void phase_scan(const Params& P) {
    float* HU = (float*)(P.ws + WS_HU); const float* HD = (const float*)(P.ws + WS_HD);
    for (int e = blockIdx.x * 512 + threadIdx.x; e < 16 * 16384; e += gridDim.x * 512) {
        const int s = e >> 14, el = e & 16383, dk = el >> 7;
        float u[32], d[32];
#pragma unroll
        for (int sc = 0; sc < 32; ++sc) { const size_t it = (size_t)s * 32 + sc; u[sc] = HU[it * 16384 + el]; d[sc] = HD[it * 128 + dk]; }
        float carry = 0.f;
#pragma unroll
        for (int sc = 0; sc < 32; ++sc) {
            const size_t it = (size_t)s * 32 + sc;
            HU[it * 16384 + el] = carry;
            carry = d[sc] * carry + u[sc];
        }
        P.out[OUT_SP + e] = carry;
    }
}

__global__ void __launch_bounds__(512, 2) mk_fwd(Params P, int ph_lo, int ph_hi) {
    extern __shared__ __attribute__((aligned(16))) unsigned char shm[];
    cg::grid_group grid = cg::this_grid();
    const int tid = threadIdx.x, w = __builtin_amdgcn_readfirstlane(tid >> 6), lane = tid & 63;
#define IN_PH(p) (ph_lo <= (p) && (p) < ph_hi)
#define PH_LOOP(p) for (int rep = 0; rep < ((PROBE_DUP == (p)) ? 2 : 1); ++rep)
    volatile LAS unsigned* xst = (volatile LAS unsigned*)((LAS unsigned char*)shm + 131072);
    if (tid == 0) { xst[0] = 0u; xst[1] = 0u; }
    __syncthreads();
    (void)xcd_barrier_post((unsigned*)(P.ws + WS_BAR), xst);
#define XBAR() xcd_barrier((unsigned*)(P.ws + WS_BAR), (volatile LAS unsigned*)((LAS unsigned char*)shm + 131072))
#define PH_SYNC if (rep) XBAR()
#define SEAM(p) do { if (ph_lo <= (p) && (p) + 1 < ph_hi) XBAR(); } while (0)
    if (ph_hi > NPHASE + 1) grid.sync();
    if (PROBE_DUP == 100) { for (int r = 0; r < 10; ++r) XBAR(); }
    if (IN_PH(0)) PH_LOOP(0) { PH_SYNC; phase_prep(P, shm); }
    SEAM(0);
    if (IN_PH(1)) PH_LOOP(1) { PH_SYNC;
        pg8::Gemm g{(const bf16_t*)(P.ws + WS_XB), (const bf16_t*)(P.ws + WS_WIN), MP, INW, DM};
        pg8::StaticOrder S; S.init(MP, INW, DM, gridDim.x, blockIdx.x, 0);
        EpiIn E{(bf16_t*)(P.ws + WS_PROJ), (const float*)(P.ws + WS_RSTD1), (const float*)(P.ws + WS_LB)};
        pg8::gemm_phase<EpiIn>((LAS unsigned char*)shm, g, S, E);
        {
            const int G = gridDim.x, nfull = (MP / 256 * (INW / 256)) % G;
            const int total = 16 * 44 + 16 * 16 + 2 * 16 * 44 + 44 * 16;
            if (nfull == 0) prep_weights(P, shm, 16 * 44, total, blockIdx.x, G);
            else if ((int)blockIdx.x >= nfull) prep_weights(P, shm, 16 * 44, total, blockIdx.x - nfull, G - nfull);
        }
    }
    SEAM(1);
    if (IN_PH(2)) PH_LOOP(2) { PH_SYNC;
        for (int i = blockIdx.x; i < 512; i += gridDim.x) hgrn_state_item(P, shm, i);
        for (int i = blockIdx.x; i < 1280; i += gridDim.x) {
            if (i < 512) attn_prompt_item(P, shm, i);
            else if (i < 768) dec_attn_item(P, shm, i - 512);
            else dec_hgrn_item(P, shm, i - 768);
        }
    }
    SEAM(2);
    if (IN_PH(3)) phase_scan(P);
    SEAM(3);
    if (IN_PH(4)) PH_LOOP(4) { PH_SYNC;
        for (int i = blockIdx.x; i < 512; i += gridDim.x) hgrn_item<true>(P, shm, i);
    }
    SEAM(4);
    if (IN_PH(5)) PH_LOOP(5) { PH_SYNC;
        pg8::Gemm g{(const bf16_t*)(P.ws + WS_MIX), (const bf16_t*)(P.ws + WS_WOUT), MP, DM, DM};
        pg8::StaticOrder S; S.init(TP, DM, DM, gridDim.x, blockIdx.x, rep ? 0 : 4 * (DM / 256));
        EpiSq E{(bf16_t*)(P.ws + WS_MIXO), (float*)(P.ws + WS_SS2), (float*)(P.ws + WS_S2)};
        pg8::gemm_phase<EpiSq>((LAS unsigned char*)shm, g, S, E);
    }
    SEAM(5);
    if (IN_PH(6)) PH_LOOP(6) { PH_SYNC;
        bf16_t* x1b = (bf16_t*)(P.ws + WS_XB); float* rstd3 = (float*)(P.ws + WS_RSTD3);
        const bf16_t* mixo = (const bf16_t*)(P.ws + WS_MIXO); const float* ss2 = (const float*)(P.ws + WS_SS2);
        const int NW = gridDim.x * 8;
        for (int rb = blockIdx.x * 8 + w; rb < NS; rb += NW) {
            const int row = TP + rb;
            const float* sp = (const float*)(P.ws + WS_S2) + (size_t)rb * DM;
            f32x4 v[4]; float ssm = 0.f;
#pragma unroll
            for (int i = 0; i < 4; ++i) {
                v[i] = *(const f32x4*)(sp + i * 256 + lane * 4);
#pragma unroll
                for (int k = 1; k < 4; ++k) v[i] += *(const f32x4*)(sp + (size_t)k * (NS * DM) + i * 256 + lane * 4);
                ssm += v[i][0] * v[i][0] + v[i][1] * v[i][1] + v[i][2] * v[i][2] + v[i][3] * v[i][3];
            }
            const float r2 = rsqrtf(wave_sum(ssm) * (1.0f / DM) + EPS);
            float ss = 0.f;
#pragma unroll
            for (int i = 0; i < 4; ++i) {
                const u32x2 xw = *(const u32x2*)(x1b + (size_t)row * DM + i * 256 + lane * 4);
                const f32x4 gv = *(const f32x4*)(P.g2 + i * 256 + lane * 4);
                const float a0 = lo_bf(xw.x) + v[i][0] * r2 * gv[0], a1 = hi_bf(xw.x) + v[i][1] * r2 * gv[1], a2 = lo_bf(xw.y) + v[i][2] * r2 * gv[2], a3 = hi_bf(xw.y) + v[i][3] * r2 * gv[3];
                ss += a0 * a0 + a1 * a1 + a2 * a2 + a3 * a3;
                u32x2 o; o.x = cvt_pk_bf16(a0, a1); o.y = cvt_pk_bf16(a2, a3);
                *(u32x2*)(x1b + (size_t)row * DM + i * 256 + lane * 4) = o;
            }
            ss = wave_sum(ss);
            if (lane == 0) rstd3[row] = rsqrtf(ss * (1.0f / DM) + EPS);
        }
        for (int rowa = blockIdx.x * 8 + w; rowa < TP; rowa += 4 * NW) {
            u32x2 xw[4][4], mw[4][4]; float sv[4];
#pragma unroll
            for (int r = 0; r < 4; ++r) {
                const int row = min(rowa + r * NW, TP - 1);
                sv[r] = lane < 16 ? ss2[(size_t)row * 16 + lane] : 0.f;
#pragma unroll
                for (int i = 0; i < 4; ++i) { xw[r][i] = __builtin_nontemporal_load((const u32x2*)(x1b + (size_t)row * DM + i * 256 + lane * 4)); mw[r][i] = *(const u32x2*)(mixo + (size_t)row * DM + i * 256 + lane * 4); }
            }
#pragma unroll
            for (int r = 0; r < 4; ++r) {
                const int row = rowa + r * NW;
                const float r2 = rsqrtf(wave_sum(sv[r]) * (1.0f / DM) + EPS);
                float ss = 0.f;
                u32x2 o[4];
#pragma unroll
                for (int i = 0; i < 4; ++i) {
                    const f32x4 gv = *(const f32x4*)(P.g2 + i * 256 + lane * 4);
                    const float a0 = lo_bf(xw[r][i].x) + lo_bf(mw[r][i].x) * r2 * gv[0], a1 = hi_bf(xw[r][i].x) + hi_bf(mw[r][i].x) * r2 * gv[1];
                    const float a2 = lo_bf(xw[r][i].y) + lo_bf(mw[r][i].y) * r2 * gv[2], a3 = hi_bf(xw[r][i].y) + hi_bf(mw[r][i].y) * r2 * gv[3];
                    ss += a0 * a0 + a1 * a1 + a2 * a2 + a3 * a3;
                    o[i].x = cvt_pk_bf16(a0, a1); o[i].y = cvt_pk_bf16(a2, a3);
                }
                ss = wave_sum(ss);
                if (row < TP) {
#pragma unroll
                    for (int i = 0; i < 4; ++i) *(u32x2*)(x1b + (size_t)row * DM + i * 256 + lane * 4) = o[i];
                    if (lane == 0) rstd3[row] = rsqrtf(ss * (1.0f / DM) + EPS);
                }
            }
        }
    }
    SEAM(6);
    if (IN_PH(7)) PH_LOOP(7) { PH_SYNC;
        pg8::Gemm g{(const bf16_t*)(P.ws + WS_XB), (const bf16_t*)(P.ws + WS_WGU), MP, 2 * DFF, DM};
        pg8::StaticOrder S; S.init(TP, 2 * DFF, DM, gridDim.x, blockIdx.x, rep ? 0 : 22 * (DM / 256));
        EpiGU E{(bf16_t*)(P.ws + WS_PROJ), (const float*)(P.ws + WS_RSTD3), (float*)(P.ws + WS_S3)};
        pg8::gemm_phase<EpiGU>((LAS unsigned char*)shm, g, S, E);
    }
    SEAM(7);
    if (IN_PH(8)) PH_LOOP(8) { PH_SYNC;
        pg8::Gemm g{(const bf16_t*)(P.ws + WS_PROJ), (const bf16_t*)(P.ws + WS_WDN), MP, DM, DFF};
        pg8::StaticOrder S; S.init(TP, DM, DFF, gridDim.x, blockIdx.x, rep ? 0 : 4 * (DFF / 256));
        for (int i = 0;; ++i) {
            const long L = (long)i * gridDim.x + blockIdx.x;
            if (L >= 512 + S.nextra) break;
            if (L < 512) continue;
            const int ks = (int)((L - 512) / 4);
            const float* s3 = (const float*)(P.ws + WS_S3); const float* rstd3 = (const float*)(P.ws + WS_RSTD3);
            bf16_t* actp = (bf16_t*)(P.ws + WS_PROJ);
#pragma unroll 2
            for (int e = tid; e < 128 * 64; e += 512) {
                const int row = e >> 6, j = (e & 63) * 4, f = ks * 256 + j;
                const float rs = rstd3[TP + row];
                const float* gp = s3 + (size_t)row * (2 * DFF) + (f >> 7) * 256 + (f & 127);
                f32x4 g = *(const f32x4*)gp, u = *(const f32x4*)(gp + 128);
#pragma unroll
                for (int k = 1; k < 4; ++k) { const float* gk = gp + (size_t)k * (NS * 2 * DFF); g += *(const f32x4*)gk; u += *(const f32x4*)(gk + 128); }
                g *= rs; u *= rs;
                u32x2 o; o.x = cvt_pk_bf16(silu_f(g[0]) * u[0], silu_f(g[1]) * u[1]); o.y = cvt_pk_bf16(silu_f(g[2]) * u[2], silu_f(g[3]) * u[3]);
                *(u32x2*)(actp + (size_t)(TP + row) * DFF + f) = o;
            }
            asm volatile("s_waitcnt vmcnt(0)" ::: "memory");
            __syncthreads();
        }
        EpiSq E{(bf16_t*)(P.ws + WS_MIX), (float*)(P.ws + WS_SS4), (float*)(P.ws + WS_S4)};
        pg8::gemm_phase<EpiSq>((LAS unsigned char*)shm, g, S, E);
    }
    SEAM(8);
    if (IN_PH(9)) PH_LOOP(9) { PH_SYNC;
        const bf16_t* x1b = (const bf16_t*)(P.ws + WS_XB); const bf16_t* ffo = (const bf16_t*)(P.ws + WS_MIX); const float* ss4 = (const float*)(P.ws + WS_SS4);
        const int NW = gridDim.x * 8;
        for (int rb = blockIdx.x * 8 + w; rb < NS; rb += NW) {
            const float* sp = (const float*)(P.ws + WS_S4) + (size_t)rb * DM;
            f32x4 v[4]; float ssm = 0.f;
#pragma unroll
            for (int i = 0; i < 4; ++i) {
                v[i] = *(const f32x4*)(sp + i * 256 + lane * 4);
#pragma unroll
                for (int k = 1; k < 11; ++k) v[i] += *(const f32x4*)(sp + (size_t)k * (NS * DM) + i * 256 + lane * 4);
                ssm += v[i][0] * v[i][0] + v[i][1] * v[i][1] + v[i][2] * v[i][2] + v[i][3] * v[i][3];
            }
            const float r4 = rsqrtf(wave_sum(ssm) * (1.0f / DM) + EPS);
            float* dst = P.out + OUT_YS + (size_t)rb * DM;
#pragma unroll
            for (int i = 0; i < 4; ++i) {
                const u32x2 xw = *(const u32x2*)(x1b + (size_t)(TP + rb) * DM + i * 256 + lane * 4);
                const f32x4 gv = *(const f32x4*)(P.g4 + i * 256 + lane * 4);
                f32x4 y;
                y[0] = lo_bf(xw.x) + v[i][0] * r4 * gv[0]; y[1] = hi_bf(xw.x) + v[i][1] * r4 * gv[1]; y[2] = lo_bf(xw.y) + v[i][2] * r4 * gv[2]; y[3] = hi_bf(xw.y) + v[i][3] * r4 * gv[3];
                *(f32x4*)(dst + i * 256 + lane * 4) = y;
            }
        }
        for (int rowa = blockIdx.x * 8 + w; rowa < TP; rowa += 4 * NW) {
            u32x2 xw[4][4], fw[4][4]; float sv[4];
#pragma unroll
            for (int r = 0; r < 4; ++r) {
                const int row = min(rowa + r * NW, TP - 1);
                sv[r] = lane < 16 ? ss4[(size_t)row * 16 + lane] : 0.f;
#pragma unroll
                for (int i = 0; i < 4; ++i) { xw[r][i] = *(const u32x2*)(x1b + (size_t)row * DM + i * 256 + lane * 4); fw[r][i] = *(const u32x2*)(ffo + (size_t)row * DM + i * 256 + lane * 4); }
            }
#pragma unroll
            for (int r = 0; r < 4; ++r) {
                const int row = rowa + r * NW;
                const float r4 = rsqrtf(wave_sum(sv[r]) * (1.0f / DM) + EPS);
                if (row < TP) {
                    float* dst = P.out + OUT_YP + (size_t)row * DM;
#pragma unroll
                    for (int i = 0; i < 4; ++i) {
                        const f32x4 gv = *(const f32x4*)(P.g4 + i * 256 + lane * 4);
                        f32x4 y;
                        y[0] = lo_bf(xw[r][i].x) + lo_bf(fw[r][i].x) * r4 * gv[0]; y[1] = hi_bf(xw[r][i].x) + hi_bf(fw[r][i].x) * r4 * gv[1];
                        y[2] = lo_bf(xw[r][i].y) + lo_bf(fw[r][i].y) * r4 * gv[2]; y[3] = hi_bf(xw[r][i].y) + hi_bf(fw[r][i].y) * r4 * gv[3];
                        __builtin_nontemporal_store(y, (f32x4*)(dst + i * 256 + lane * 4));
                    }
                }
            }
        }
    }
#undef IN_PH
#undef SEAM
}

extern "C" void kernel_launch(void* const* d_in, const int* in_sizes, int n_in, void* d_out, int out_size, void* d_ws, size_t ws_size, hipStream_t stream) {
    static int grid = 0;
    if (grid == 0) {
        if (n_in != 17 || ws_size < WS_END) { fprintf(stderr, "kernel_launch: unexpected inputs (n_in %d, ws %zu, need %zu)\n", n_in, ws_size, (size_t)WS_END); grid = -1; return; }
        int dev = 0, cus = 0, per_cu = 0;
        hipGetDevice(&dev);
        hipDeviceGetAttribute(&cus, hipDeviceAttributeMultiprocessorCount, dev);
        if (hipFuncSetAttribute((const void*)mk_fwd, hipFuncAttributeMaxDynamicSharedMemorySize, LDS_BYTES) != hipSuccess) { fprintf(stderr, "kernel_launch: hipFuncSetAttribute failed\n"); grid = -1; return; }
        if (hipOccupancyMaxActiveBlocksPerMultiprocessor(&per_cu, (const void*)mk_fwd, 512, LDS_BYTES) != hipSuccess || per_cu < 1) { fprintf(stderr, "kernel_launch: occupancy query failed (%d)\n", per_cu); grid = -1; return; }
        grid = cus * per_cu;
    }
    if (grid < 0) return;
    if (hipMemsetAsync((char*)d_ws + WS_BAR, 0, 3456 * 4, stream) != hipSuccess) { fprintf(stderr, "kernel_launch: memset of the barrier words failed\n"); return; }
    Params p{};
    p.xp = (const float*)d_in[0]; p.xs = (const float*)d_in[1]; p.ck = (const float*)d_in[2]; p.cv = (const float*)d_in[3]; p.st = (const float*)d_in[4];
    p.w_in = (const float*)d_in[5]; p.w_out = (const float*)d_in[6]; p.w_gate = (const float*)d_in[7]; p.w_up = (const float*)d_in[8]; p.w_down = (const float*)d_in[9];
    p.g1 = (const float*)d_in[10]; p.g2 = (const float*)d_in[11]; p.g3 = (const float*)d_in[12]; p.g4 = (const float*)d_in[13];
    p.sinks = (const float*)d_in[14]; p.rec_lb = (const float*)d_in[15]; p.rec_norm = (const float*)d_in[16];
    p.out = (float*)d_out; p.ws = (unsigned char*)d_ws;
#if N_LAUNCH_MODE == 1
    for (int ph = 0; ph < NPHASE; ++ph) hipLaunchKernelGGL(mk_fwd, dim3(grid), dim3(512), LDS_BYTES, stream, p, ph, ph + 1);
#else
    int lo = 0, hi = NPHASE;
    void* args[] = {&p, &lo, &hi};
    hipError_t e = hipLaunchCooperativeKernel((const void*)mk_fwd, dim3(grid), dim3(512), args, LDS_BYTES, stream);
    if (e != hipSuccess) fprintf(stderr, "cooperative launch failed: %s (grid %d)\n", hipGetErrorString(e), grid);
#endif
}
```

```cpp
#include <hip/hip_runtime.h>
#include <hip/hip_cooperative_groups.h>
#include <cstdio>
namespace cg = cooperative_groups;

#define LAS __attribute__((address_space(3)))
typedef unsigned short bf16_t;
typedef short bf16x8 __attribute__((ext_vector_type(8)));
typedef short bf16x4 __attribute__((ext_vector_type(4)));
typedef float f32x4 __attribute__((ext_vector_type(4)));
typedef unsigned u32x4 __attribute__((ext_vector_type(4)));
typedef unsigned u32x2 __attribute__((ext_vector_type(2)));

#ifndef N_LAUNCH_MODE
#define N_LAUNCH_MODE 0
#endif

constexpr int DM = 1024, TP = 32768, SEQ = 8192, NS = 128, MP = TP + 256, INW = 2816, DFF = 2816;
constexpr float EPS = 1e-6f;
constexpr int NPHASE = 10;
#ifndef PROBE_DUP
#define PROBE_DUP -1
#endif
constexpr int LDS_BYTES = 131072 + 16;

constexpr size_t al(size_t x) { return (x + 255) & ~(size_t)255; }
constexpr size_t WS_XB = 0;
constexpr size_t WS_PROJ = WS_XB + al((size_t)MP * DM * 2);
constexpr size_t WS_MIX = WS_PROJ + al((size_t)MP * INW * 2);
constexpr size_t WS_MIXO = WS_MIX + al((size_t)MP * DM * 2);
constexpr size_t WS_WIN = WS_MIXO + al((size_t)MP * DM * 2);
constexpr size_t WS_WOUT = WS_WIN + al((size_t)INW * DM * 2);
constexpr size_t WS_WGU = WS_WOUT + al((size_t)DM * DM * 2);
constexpr size_t WS_WDN = WS_WGU + al((size_t)2 * DFF * DM * 2);
constexpr size_t WS_RSTD1 = WS_WDN + al((size_t)DM * DFF * 2);
constexpr size_t WS_RSTD3 = WS_RSTD1 + al((size_t)MP * 4);
constexpr size_t WS_SS2 = WS_RSTD3 + al((size_t)MP * 4);
constexpr size_t WS_SS4 = WS_SS2 + al((size_t)MP * 16 * 4);
constexpr size_t WS_ROPE = WS_SS4 + al((size_t)MP * 16 * 4);
constexpr size_t WS_LB = WS_ROPE + al((size_t)8193 * 8 * 8);
constexpr size_t WS_HU = WS_LB + al(512 * 4);
constexpr size_t WS_HD = WS_HU + al((size_t)16 * 32 * 16384 * 4);
constexpr size_t WS_S2 = WS_HD + al((size_t)16 * 32 * 128 * 4);
constexpr size_t WS_S4 = WS_S2 + al((size_t)4 * NS * DM * 4);
constexpr size_t WS_S3 = WS_S4 + al((size_t)11 * NS * DM * 4);
constexpr size_t WS_BAR = WS_S3 + al((size_t)4 * NS * 2 * DFF * 4);
constexpr size_t WS_END = WS_BAR + al((size_t)3456 * 4);

constexpr size_t OUT_YP = 0;
constexpr size_t OUT_YS = OUT_YP + (size_t)TP * DM;
constexpr size_t OUT_KP = OUT_YS + (size_t)NS * DM;
constexpr size_t OUT_VP = OUT_KP + 65536;
constexpr size_t OUT_SP = OUT_VP + 65536;
constexpr size_t OUT_KS = OUT_SP + 262144;
constexpr size_t OUT_VS = OUT_KS + 2097152;
constexpr size_t OUT_SS = OUT_VS + 2097152;

struct Params {
    const float *xp, *xs, *ck, *cv, *st, *w_in, *w_out, *w_gate, *w_up, *w_down, *g1, *g2, *g3, *g4, *sinks, *rec_lb, *rec_norm;
    float* out; unsigned char* ws;
};

__device__ __forceinline__ float bf2f(bf16_t b) { return __uint_as_float(((unsigned)b) << 16); }
typedef float f32x2 __attribute__((ext_vector_type(2)));
typedef __bf16 bf16x2_t __attribute__((ext_vector_type(2)));
__device__ __forceinline__ bf16_t f2bf(float f) { const __bf16 b = (__bf16)f; bf16_t r; __builtin_memcpy(&r, &b, 2); return r; }
__device__ __forceinline__ unsigned cvt_pk_bf16(float lo, float hi) { const f32x2 v = {lo, hi}; const bf16x2_t b = __builtin_convertvector(v, bf16x2_t); unsigned r; __builtin_memcpy(&r, &b, 4); return r; }
__device__ __forceinline__ float lo_bf(unsigned u) { return __uint_as_float(u << 16); }
__device__ __forceinline__ float hi_bf(unsigned u) { return __uint_as_float(u & 0xFFFF0000u); }
__device__ __forceinline__ float silu_f(float x) { return x * __builtin_amdgcn_rcpf(1.0f + __expf(-x)); }
template <int CTRL> __device__ __forceinline__ float dpp_f(float v) {
    return __int_as_float(__builtin_amdgcn_update_dpp(0, __float_as_int(v), CTRL, 0xF, 0xF, true));
}
__device__ __forceinline__ float lane_f(float v, int l) { return __int_as_float(__builtin_amdgcn_readlane(__float_as_int(v), l)); }
__device__ __forceinline__ float wave_sum(float v) {
    v += dpp_f<0xB1>(v);
    v += dpp_f<0x4E>(v);
    v += dpp_f<0x141>(v);
    v += dpp_f<0x140>(v);
    return (lane_f(v, 0) + lane_f(v, 16)) + (lane_f(v, 32) + lane_f(v, 48));
}
__device__ __forceinline__ float wave_max(float v) {
    v = fmaxf(v, dpp_f<0xB1>(v));
    v = fmaxf(v, dpp_f<0x4E>(v));
    v = fmaxf(v, dpp_f<0x141>(v));
    v = fmaxf(v, dpp_f<0x140>(v));
    return fmaxf(fmaxf(lane_f(v, 0), lane_f(v, 16)), fmaxf(lane_f(v, 32), lane_f(v, 48)));
}
__device__ __forceinline__ void swap16(float x, float& a, float& b) { const auto r = __builtin_amdgcn_permlane16_swap(__float_as_uint(x), __float_as_uint(x), false, false); a = __uint_as_float(r[0]); b = __uint_as_float(r[1]); }
__device__ __forceinline__ void swap32(float x, float& a, float& b) { const auto r = __builtin_amdgcn_permlane32_swap(__float_as_uint(x), __float_as_uint(x), false, false); a = __uint_as_float(r[0]); b = __uint_as_float(r[1]); }
__device__ __forceinline__ float xsum_rows(float x) { float a, b; swap16(x, a, b); x = a + b; swap32(x, a, b); return a + b; }
__device__ __forceinline__ float xmax_rows(float x) { float a, b; swap16(x, a, b); x = fmaxf(a, b); swap32(x, a, b); return fmaxf(a, b); }
#define MFMA16(a, b, c) __builtin_amdgcn_mfma_f32_16x16x32_bf16(a, b, c, 0, 0, 0)


#define XB_TMO      128
#define XB_XCNT(j)  (256  + 64 * (j))
#define XB_XSUB(j)  (1280 + 64 * (j))
#define XB_XGEN(j)  (2304 + 64 * (j))
#define XB_TOP      3328
#define XB_TOPGEN   3392
#define XCD_BAR_WORDS 3456
#define XB_SPIN_CAP (1u << 18)
__device__ __forceinline__ unsigned xb_ld(unsigned* p)              { return __hip_atomic_load(p, __ATOMIC_RELAXED, __HIP_MEMORY_SCOPE_AGENT); }
__device__ __forceinline__ unsigned xb_add(unsigned* p, unsigned v) { return __hip_atomic_fetch_add(p, v, __ATOMIC_RELAXED, __HIP_MEMORY_SCOPE_AGENT); }
__device__ __forceinline__ unsigned xb_xcc_id() { return (unsigned)__builtin_amdgcn_s_getreg((3 << 11) | 20) & 0xFu; }
#define XB_SPIN(cond, bar) do { unsigned _sp = 0; while (cond) { __builtin_amdgcn_s_sleep(1); \
    if ((++_sp & 255u) == 0u) { if (xb_ld(&(bar)[XB_TMO])) break; if (_sp > XB_SPIN_CAP) { atomicAdd(&(bar)[XB_TMO], 1u); break; } } } } while (0)
struct XcdBarrier { unsigned* bar; unsigned x; volatile LAS unsigned* st; };
__device__ __forceinline__ XcdBarrier xcd_barrier_post(unsigned* bar, volatile LAS unsigned* st) {
    XcdBarrier b; b.bar = bar; b.x = xb_xcc_id(); b.st = st;
    if (threadIdx.x == 0) (void)xb_add(&bar[XB_XCNT(b.x)], 1u);
    return b;
}
__device__ __forceinline__ void xcd_barrier_complete(unsigned* bar, unsigned x, unsigned& nloc, unsigned& nx) {
    const unsigned G = gridDim.x * gridDim.y * gridDim.z;
    unsigned sum, cnt, mine, sp = 0u;
    for (;;) {
        sum = 0u; cnt = 0u; mine = 0u;
#pragma unroll
        for (unsigned j = 0; j < 16; ++j) { const unsigned c = xb_ld(&bar[XB_XCNT(j)]); sum += c; cnt += (c > 0u) ? 1u : 0u; mine = (j == x) ? c : mine; }
        if (sum == G) break;
        __builtin_amdgcn_s_sleep(1);
        if ((++sp & 255u) == 0u) { if (xb_ld(&bar[XB_TMO])) break; if (sp > XB_SPIN_CAP) { atomicAdd(&bar[XB_TMO], 1u); break; } }
    }
    nloc = mine > 0u ? mine : 1u; nx = cnt > 0u ? cnt : 1u;
}
__device__ __forceinline__ void xcd_barrier(unsigned* bar_, volatile LAS unsigned* st_) {
    XcdBarrier b; b.bar = bar_; b.x = xb_xcc_id(); b.st = st_;
    asm volatile("s_waitcnt vmcnt(0)" ::: "memory");
    __syncthreads();
    if (threadIdx.x == 0) {
        unsigned* bar = b.bar;
        __builtin_amdgcn_s_waitcnt(0);
        unsigned nloc = b.st[0], nx = b.st[1];
        if (nloc == 0u) { xcd_barrier_complete(bar, b.x, nloc, nx); b.st[0] = nloc; b.st[1] = nx; }
        const unsigned old = xb_add(&bar[XB_XSUB(b.x)], 1u);
        const unsigned gen = old / nloc;
        if (old + 1u == (gen + 1u) * nloc) {
            __builtin_amdgcn_fence(__ATOMIC_RELEASE, "agent");
            asm volatile("s_waitcnt vmcnt(0)" ::: "memory");
            const unsigned og = xb_add(&bar[XB_TOP], 1u);
            const unsigned tg = og / nx;
            if (og + 1u == (tg + 1u) * nx) xb_add(&bar[XB_TOPGEN], 1u);
            else XB_SPIN(xb_ld(&bar[XB_TOPGEN]) == tg, bar);
            __builtin_amdgcn_fence(__ATOMIC_ACQUIRE, "agent");
            xb_add(&bar[XB_XGEN(b.x)], 1u);
            asm volatile("s_waitcnt vmcnt(0)" ::: "memory");
        } else {
            XB_SPIN(xb_ld(&bar[XB_XGEN(b.x)]) == gen, bar);
            __builtin_amdgcn_fence(__ATOMIC_ACQUIRE, "agent");
            asm volatile("s_waitcnt vmcnt(0)" ::: "memory");
        }
    }
    __syncthreads();
}

namespace pg8 {
constexpr int BM = 256, BK = 64, HALF = 128, HTB = HALF * BK * 2, NXCD = 8, WGM = 8;
__device__ __forceinline__ int lds_byte(int r, int c) { const int st = (r >> 4) * 2 + (c >> 5), rr = r & 15, cc = c & 31, ob = rr * 64 + cc * 2; return st * 1024 + (ob ^ (((ob >> 9) & 1) << 5)); }
__device__ __forceinline__ void stage_rc(int b, int& R, int& C) { const int st = b / 1024, sb = b % 1024, swz = sb ^ (((sb >> 9) & 1) << 5); R = (st >> 1) * 16 + swz / 64; C = (st & 1) * 32 + (swz % 64) / 2; }
__device__ __forceinline__ int perm32(int rho) { const int n = rho >> 4, i = rho & 15; return 8 * (i >> 2) + 4 * n + (i & 3); }
struct Unit { int pm, pn, koff, nt, mini; };
struct Gemm { const bf16_t* A; const bf16_t* Bt; int M, N, K; };
struct StaticOrder {
    int nM, nN, nwg, G, c, ntm, nextra;
    __device__ void init(int M, int N, int K, int G_, int c_, int nextra_) { nM = M / BM; nN = N / BM; nwg = nM * nN; G = G_; c = c_; ntm = K / BK; nextra = nextra_; }
    __device__ bool next(int i, Unit& u) const {
        const long L = (long)i * G + c;
        if (L >= nwg) {
            const long e = L - nwg; if (e >= nextra) return false;
            u.pm = nM; u.pn = (int)(e % nN); u.koff = (int)(e / nN) * 512; u.nt = 4; u.mini = 1; return true;
        }
        int wgid = (int)L; { const int q = nwg / NXCD, r = nwg % NXCD, xcd = wgid % NXCD, off = wgid / NXCD; wgid = (xcd < r ? xcd * (q + 1) : r * (q + 1) + (xcd - r) * q) + off; }
        const int nig = WGM * nN, gid = wgid / nig, fm = gid * WGM, gsz = (nM - fm) < WGM ? (nM - fm) : WGM;
        u.pm = fm + ((wgid % nig) % gsz); u.pn = (wgid % nig) / gsz; u.koff = 0; u.nt = ntm; u.mini = 0; return true;
    }
};

template <class Epi>
__device__ __forceinline__ void gemm_phase(LAS unsigned char* lds, const Gemm g, const StaticOrder& S, const Epi& E) {
    const int tid = threadIdx.x, wid = __builtin_amdgcn_readfirstlane(tid >> 6), lane = tid & 63, wr = wid >> 2, wc = wid & 3, fr = lane & 15, fq = lane >> 4;
    const int K = g.K;
    unsigned voffA[2], voffB[2];
#pragma unroll
    for (int i = 0; i < 2; ++i) { int R, C; stage_rc(tid * 16 + i * 8192, R, C); const int Rb = (R & ~31) + perm32(R & 31);
        voffA[i] = (unsigned)(R * K + C) * 2u; voffB[i] = (unsigned)(Rb * K + C) * 2u; }
    const size_t kstep = (size_t)(BK * 2);
    const size_t hstep = (size_t)HALF * K * 2;
    const size_t tstep = 2 * hstep;
    const unsigned ldsw = (unsigned)wid * 1024u;
    const int aoff = lds_byte(wr * 64 + fr, fq * 8), boff = lds_byte(wc * 32 + fr, fq * 8);
#define PG8_SA(b, h) (((b) * 2 + (h)) * HTB)
#define PG8_SB(b, h) ((4 + (b) * 2 + (h)) * HTB)
#define PG8_STAGE(bufoff, gbase, voff) do { _Pragma("unroll") for (int _i = 0; _i < 2; ++_i) \
        __builtin_amdgcn_global_load_lds((const unsigned*)((const char*)(gbase) + (voff)[_i]), (LAS unsigned*)(lds + (bufoff) + ldsw + _i * 8192), 16, 0, 0); } while (0)
#define PG8_LDA(dst, b, h) do { _Pragma("unroll") for (int m = 0; m < 4; ++m) _Pragma("unroll") for (int k = 0; k < 2; ++k) dst[m][k] = *(const LAS bf16x8*)(lds + PG8_SA(b, h) + aoff + m * 2048 + k * 1024); } while (0)
#define PG8_LDB(dst, b, h) do { _Pragma("unroll") for (int n = 0; n < 2; ++n) _Pragma("unroll") for (int k = 0; k < 2; ++k) dst[n][k] = *(const LAS bf16x8*)(lds + PG8_SB(b, h) + boff + n * 2048 + k * 1024); } while (0)
#define PG8_MMA(ai, bj, At, Bt) do { __builtin_amdgcn_s_setprio(1); _Pragma("unroll") for (int m = 0; m < 4; ++m) _Pragma("unroll") for (int n = 0; n < 2; ++n) _Pragma("unroll") for (int k = 0; k < 2; ++k) \
        acc[ai][bj][m][n] = __builtin_amdgcn_mfma_f32_16x16x32_bf16(Bt[n][k], At[m][k], acc[ai][bj][m][n], 0, 0, 0); __builtin_amdgcn_s_setprio(0); } while (0)
#define PG8_WAIT_V(n) asm volatile("s_waitcnt vmcnt(" #n ")" ::: "memory")
#define PG8_WAIT_L(n) asm volatile("s_waitcnt lgkmcnt(" #n ")" ::: "memory")
#define PG8_BAR __builtin_amdgcn_s_barrier()
#define PG8_SCHED __builtin_amdgcn_sched_barrier(0)
    Unit cur, nxt; int ui = 0;
    if (!S.next(0, cur)) return;
    f32x4 acc[2][2][4][2];
#pragma unroll
    for (int a = 0; a < 2; ++a)
#pragma unroll
        for (int b = 0; b < 2; ++b)
#pragma unroll
            for (int m = 0; m < 4; ++m)
#pragma unroll
                for (int n = 0; n < 2; ++n) acc[a][b][m][n] = (f32x4){0.f, 0.f, 0.f, 0.f};
    bf16x8 At[4][2], B0[2][2], B1[2][2];
    const char* cA = (const char*)g.A + (size_t)cur.pm * tstep + cur.koff; const char* cB = (const char*)g.Bt + (size_t)cur.pn * tstep + cur.koff;
    PG8_STAGE(PG8_SB(0, 0), cB, voffB); PG8_STAGE(PG8_SA(0, 0), cA, voffA); PG8_STAGE(PG8_SB(0, 1), cB + hstep, voffB); PG8_STAGE(PG8_SA(0, 1), cA + hstep, voffA);
    if (wr == 1) PG8_BAR;
    PG8_WAIT_V(4); PG8_BAR;
    PG8_STAGE(PG8_SB(1, 0), cB + kstep, voffB); PG8_STAGE(PG8_SA(1, 0), cA + kstep, voffA); PG8_STAGE(PG8_SB(1, 1), cB + hstep + kstep, voffB);
    PG8_WAIT_V(6); PG8_BAR;
    for (;;) {
        const bool has_next = S.next(ui + 1, nxt);
        const char* nA = has_next ? (const char*)g.A + (size_t)nxt.pm * tstep + nxt.koff : cA; const char* nB = has_next ? (const char*)g.Bt + (size_t)nxt.pn * tstep + nxt.koff : cB;
        const int nt = cur.nt;
        for (int t = 0; t < nt; t += 2) {
            const bool last = (t == nt - 2);
            const char* a1 = cA + (size_t)(t + 1) * kstep;
            const char* a2 = last ? nA : cA + (size_t)(t + 2) * kstep; const char* b2 = last ? nB : cB + (size_t)(t + 2) * kstep;
            const char* a3 = a2 + kstep; const char* b3 = b2 + kstep;
            PG8_LDB(B0, 0, 0); PG8_SCHED; PG8_LDA(At, 0, 0); PG8_STAGE(PG8_SA(1, 1), a1 + hstep, voffA);
            PG8_WAIT_L(8); PG8_BAR; PG8_WAIT_L(0); PG8_MMA(0, 0, At, B0); PG8_BAR; PG8_SCHED;
            PG8_LDB(B1, 0, 1); PG8_STAGE(PG8_SB(0, 0), b2, voffB);
            PG8_BAR; PG8_WAIT_L(0); PG8_MMA(0, 1, At, B1); PG8_BAR;
            PG8_LDA(At, 0, 1); PG8_STAGE(PG8_SA(0, 0), a2, voffA);
            PG8_BAR; PG8_WAIT_L(0); PG8_MMA(1, 0, At, B0); PG8_BAR; PG8_SCHED;
            PG8_STAGE(PG8_SB(0, 1), b2 + hstep, voffB);
            PG8_WAIT_V(6); PG8_BAR; PG8_MMA(1, 1, At, B1); PG8_BAR;
            PG8_LDB(B0, 1, 0); PG8_SCHED; PG8_LDA(At, 1, 0); PG8_STAGE(PG8_SA(0, 1), a2 + hstep, voffA);
            PG8_WAIT_L(8); PG8_BAR; PG8_WAIT_L(0); PG8_MMA(0, 0, At, B0); PG8_BAR; PG8_SCHED;
            PG8_LDB(B1, 1, 1); PG8_STAGE(PG8_SB(1, 0), b3, voffB);
            PG8_BAR; PG8_WAIT_L(0); PG8_MMA(0, 1, At, B1); PG8_BAR;
            PG8_LDA(At, 1, 1); PG8_STAGE(PG8_SA(1, 0), a3, voffA);
            PG8_BAR; PG8_WAIT_L(0); PG8_MMA(1, 0, At, B0); PG8_BAR; PG8_SCHED;
            PG8_STAGE(PG8_SB(1, 1), b3 + hstep, voffB);
            PG8_WAIT_V(6); PG8_BAR; PG8_MMA(1, 1, At, B1); PG8_BAR;
        }
        E(acc, cur, wr, wc, fr, fq);
        if (!has_next) break;
#pragma unroll
        for (int a = 0; a < 2; ++a)
#pragma unroll
            for (int b = 0; b < 2; ++b)
#pragma unroll
                for (int m = 0; m < 4; ++m)
#pragma unroll
                    for (int n = 0; n < 2; ++n) acc[a][b][m][n] = (f32x4){0.f, 0.f, 0.f, 0.f};
        cur = nxt; cA = nA; cB = nB; ++ui;
    }
    PG8_WAIT_V(0);
    if (wr == 0) PG8_BAR;
    PG8_BAR;
#undef PG8_SA
#undef PG8_SB
#undef PG8_STAGE
#undef PG8_LDA
#undef PG8_LDB
#undef PG8_MMA
#undef PG8_WAIT_V
#undef PG8_WAIT_L
#undef PG8_BAR
#undef PG8_SCHED
}
}

struct EpiIn {
    bf16_t* proj; const float* rstd; const float* lb;
    __device__ __forceinline__ void operator()(const f32x4 (&acc)[2][2][4][2], const pg8::Unit& u, int wr, int wc, int fr, int fq) const {
        const int row0 = u.pm * 256 + wr * 64 + fr;
        const int cl = wc * 32 + 8 * fq;
        float rs[2][4];
#pragma unroll
        for (int ai = 0; ai < 2; ++ai)
#pragma unroll
            for (int m = 0; m < 4; ++m) rs[ai][m] = rstd[row0 + ai * 128 + m * 16];
        const bool is_rf = (u.pn == 5 || u.pn == 6);
        f32x4 lbv[2][2];
        if (is_rf) {
#pragma unroll
            for (int bj = 0; bj < 2; ++bj) { const float* lbp = lb + (u.pn * 2 + bj - 10) * 128 + cl; lbv[bj][0] = *(const f32x4*)lbp; lbv[bj][1] = *(const f32x4*)(lbp + 4); }
        }
#pragma unroll
        for (int bj = 0; bj < 2; ++bj) {
            const int hc = u.pn * 2 + bj;
#pragma unroll
            for (int ai = 0; ai < 2; ++ai)
#pragma unroll
                for (int m = 0; m < 4; ++m) {
                    const int row = row0 + ai * 128 + m * 16;
                    const float rsv = rs[ai][m];
                    float v[8];
#pragma unroll
                    for (int i = 0; i < 8; ++i) v[i] = acc[ai][bj][m][i >> 2][i & 3] * rsv;
                    if (hc < 5) {
                        if (hc < 4) {
#pragma unroll
                            for (int i = 0; i < 8; ++i) v[i] *= 0.18033688011112042f;
                        }
                        if ((wc & 1) == 0) {
                            const double RF[8] = {0.15915494309189535, 0.030863763404701233, 0.005985185712713706, 0.001160663641240061, 0.00022507907903927658, 4.364795279280288e-05, 8.464330808241401e-06, 1.641426262795035e-06};
                            const double pos = row < TP ? (double)(row & (SEQ - 1)) : 16384.0;
#pragma unroll
                            for (int i = 0; i < 8; ++i) {
                                float pa, pb; swap16(v[i], pa, pb);
                                const float o = (fq & 1) ? pa : pb;
                                double rv = pos * RF[i]; rv -= __builtin_floor(rv);
                                const float rf_ = (float)rv;
                                const float c = __builtin_amdgcn_cosf(rf_), sn = __builtin_amdgcn_sinf(rf_);
                                const float r0 = v[i] * c - o * sn, r1 = v[i] * c + o * sn;
                                v[i] = fq == 0 ? r0 : (fq == 1 ? r1 : v[i]);
                            }
                        }
                    } else if ((hc >= 6 && hc < 10) || hc >= 18) {
#pragma unroll
                        for (int i = 0; i < 8; ++i) v[i] = silu_f(v[i]);
                    } else if (hc >= 10 && hc < 14) {
#pragma unroll
                        for (int i = 0; i < 8; ++i) {
                            const float l = lbv[bj][i >> 2][i & 3];
                            const float sg = __builtin_amdgcn_rcpf(1.0f + __expf(-v[i]));
                            v[i] = __logf(l + (1.0f - l) * sg);
                        }
                    }
                    u32x4 w; w.x = cvt_pk_bf16(v[0], v[1]); w.y = cvt_pk_bf16(v[2], v[3]); w.z = cvt_pk_bf16(v[4], v[5]); w.w = cvt_pk_bf16(v[6], v[7]);
                    *(u32x4*)(proj + (size_t)row * INW + hc * 128 + cl) = w;
                }
        }
    }
};
struct EpiSq {
    bf16_t* O; float* ss; float* sb;
    __device__ __forceinline__ void operator()(const f32x4 (&acc)[2][2][4][2], const pg8::Unit& u, int wr, int wc, int fr, int fq) const {
        if (u.mini) {
            const int col0 = u.pn * 256 + wc * 32 + 8 * fq;
            float* slab = sb + (size_t)(u.koff >> 9) * (NS * DM);
#pragma unroll
            for (int m = 0; m < 4; ++m) {
                float* rp = slab + (size_t)(wr * 64 + m * 16 + fr) * DM + col0;
#pragma unroll
                for (int bj = 0; bj < 2; ++bj) { *(f32x4*)(rp + bj * 128) = acc[0][bj][m][0]; *(f32x4*)(rp + bj * 128 + 4) = acc[0][bj][m][1]; }
            }
            return;
        }
        const int row0 = u.pm * 256 + wr * 64 + fr;
        const int col0 = u.pn * 256 + wc * 32 + 8 * fq;
#pragma unroll
        for (int ai = 0; ai < 2; ++ai)
#pragma unroll
            for (int m = 0; m < 4; ++m) {
                const int row = row0 + ai * 128 + m * 16;
                float s = 0.f;
#pragma unroll
                for (int bj = 0; bj < 2; ++bj) {
                    const f32x4 v0 = acc[ai][bj][m][0], v1 = acc[ai][bj][m][1];
                    s += v0[0] * v0[0] + v0[1] * v0[1] + v0[2] * v0[2] + v0[3] * v0[3] + v1[0] * v1[0] + v1[1] * v1[1] + v1[2] * v1[2] + v1[3] * v1[3];
                    u32x4 w; w.x = cvt_pk_bf16(v0[0], v0[1]); w.y = cvt_pk_bf16(v0[2], v0[3]); w.z = cvt_pk_bf16(v1[0], v1[1]); w.w = cvt_pk_bf16(v1[2], v1[3]);
                    *(u32x4*)(O + (size_t)row * DM + col0 + bj * 128) = w;
                }
                s = xsum_rows(s);
                if (fq == 0) ss[(size_t)row * 16 + u.pn * 4 + wc] = s;
            }
    }
};
struct EpiGU {
    bf16_t* act; const float* rstd; float* sb;
    __device__ __forceinline__ void operator()(const f32x4 (&acc)[2][2][4][2], const pg8::Unit& u, int wr, int wc, int fr, int fq) const {
        if (u.mini) {
            const int colt = u.pn * 256 + wc * 32 + 8 * fq;
            float* slab = sb + (size_t)(u.koff >> 9) * (NS * 2 * DFF);
#pragma unroll
            for (int m = 0; m < 4; ++m) {
                float* rp = slab + (size_t)(wr * 64 + m * 16 + fr) * (2 * DFF) + colt;
#pragma unroll
                for (int bj = 0; bj < 2; ++bj) { *(f32x4*)(rp + bj * 128) = acc[0][bj][m][0]; *(f32x4*)(rp + bj * 128 + 4) = acc[0][bj][m][1]; }
            }
            return;
        }
        const int row0 = u.pm * 256 + wr * 64 + fr;
        const int col0 = u.pn * 128 + wc * 32 + 8 * fq;
        float rs[2][4];
#pragma unroll
        for (int ai = 0; ai < 2; ++ai)
#pragma unroll
            for (int m = 0; m < 4; ++m) rs[ai][m] = rstd[row0 + ai * 128 + m * 16];
#pragma unroll
        for (int ai = 0; ai < 2; ++ai)
#pragma unroll
            for (int m = 0; m < 4; ++m) {
                const int row = row0 + ai * 128 + m * 16;
                const float rsv = rs[ai][m];
                float a[8];
#pragma unroll
                for (int i = 0; i < 8; ++i) { const float gv = acc[ai][0][m][i >> 2][i & 3] * rsv, uv = acc[ai][1][m][i >> 2][i & 3] * rsv; a[i] = silu_f(gv) * uv; }
                u32x4 w; w.x = cvt_pk_bf16(a[0], a[1]); w.y = cvt_pk_bf16(a[2], a[3]); w.z = cvt_pk_bf16(a[4], a[5]); w.w = cvt_pk_bf16(a[6], a[7]);
                *(u32x4*)(act + (size_t)row * DFF + col0) = w;
            }
    }
};

struct TileInfo { const float* src; const float* gain; bf16_t* dst; int N, K, k0, n0, drow0; };
__device__ __forceinline__ TileInfo tile_info(const Params& P, int t) {
    const int T_IN = 16 * 44, T_OUT = 16 * 16, T_G = 16 * 44;
    TileInfo ti;
    int i = t;
    if (i < T_IN) { const int kt = i / 44, ntl = i % 44; ti = TileInfo{P.w_in, P.g1, (bf16_t*)(P.ws + WS_WIN), INW, DM, kt * 64, ntl * 64, ntl * 64}; return ti; }
    i -= T_IN;
    if (i < T_OUT) { const int kt = i / 16, ntl = i % 16; ti = TileInfo{P.w_out, nullptr, (bf16_t*)(P.ws + WS_WOUT), DM, DM, kt * 64, ntl * 64, ntl * 64}; return ti; }
    i -= T_OUT;
    if (i < 2 * T_G) { const int up = i >= T_G; if (up) i -= T_G; const int kt = i / 44, ntl = i % 44; const int f0 = ntl * 64;
        ti = TileInfo{up ? P.w_up : P.w_gate, P.g3, (bf16_t*)(P.ws + WS_WGU), DFF, DM, kt * 64, f0, (f0 >> 7) * 256 + (up ? 128 : 0) + (f0 & 127)}; return ti; }
    i -= 2 * T_G;
    { const int kt = i / 16, ntl = i % 16; ti = TileInfo{P.w_down, nullptr, (bf16_t*)(P.ws + WS_WDN), DM, DFF, kt * 64, ntl * 64, ntl * 64}; }
    return ti;
}
__device__ __forceinline__ void tile_load(const TileInfo& ti, int kr, int c4, f32x4& v0, f32x4& v1) {
    const float* p0 = ti.src + (size_t)(ti.k0 + kr) * ti.N + ti.n0 + c4 * 4;
    v0 = *(const f32x4*)p0; v1 = *(const f32x4*)(p0 + (size_t)32 * ti.N);
    if (ti.gain) { const float g0 = ti.gain[ti.k0 + kr], g1 = ti.gain[ti.k0 + kr + 32]; v0 *= g0; v1 *= g1; }
}

__device__ __forceinline__ void prep_weights(const Params& P, unsigned char* lds, int t0, int t1, int j, int stride) {
    const int tid = threadIdx.x;
    float* tile = (float*)lds;
    const int kr = tid >> 4, c4 = tid & 15, n = tid >> 3, kg = tid & 7;
    int t = t0 + j;
    f32x4 v0, v1; TileInfo cur;
    if (t < t1) { cur = tile_info(P, t); tile_load(cur, kr, c4, v0, v1); }
    for (; t < t1; t += stride) {
        __syncthreads();
        *(f32x4*)(tile + kr * 68 + c4 * 4) = v0; *(f32x4*)(tile + (kr + 32) * 68 + c4 * 4) = v1;
        const TileInfo me = cur;
        if (t + stride < t1) { cur = tile_info(P, t + stride); tile_load(cur, kr, c4, v0, v1); }
        __syncthreads();
        float x[8];
#pragma unroll
        for (int jj = 0; jj < 8; ++jj) x[jj] = tile[(kg * 8 + jj) * 68 + n];
        u32x4 o; o.x = cvt_pk_bf16(x[0], x[1]); o.y = cvt_pk_bf16(x[2], x[3]); o.z = cvt_pk_bf16(x[4], x[5]); o.w = cvt_pk_bf16(x[6], x[7]);
        *(u32x4*)(me.dst + (size_t)(me.drow0 + n) * me.K + me.k0 + kg * 8) = o;
    }
}

__device__ __forceinline__ void phase_prep(const Params& P, unsigned char* lds) {
    const int tid = threadIdx.x, w = __builtin_amdgcn_readfirstlane(tid >> 6), lane = tid & 63;
    {
        bf16_t* xb = (bf16_t*)(P.ws + WS_XB); float* rstd1 = (float*)(P.ws + WS_RSTD1);
        const int NW = gridDim.x * 8;
        for (int rowa = blockIdx.x * 8 + w; rowa < MP; rowa += 4 * NW) {
            f32x4 v[4][4];
#pragma unroll
            for (int r = 0; r < 4; ++r) {
                const int row = rowa + r * NW;
                const float* src = row < TP ? P.xp + (size_t)row * DM : (row < TP + NS ? P.xs + (size_t)(row - TP) * DM : nullptr);
#pragma unroll
                for (int i = 0; i < 4; ++i) { v[r][i] = (f32x4){0.f, 0.f, 0.f, 0.f}; if (src) v[r][i] = __builtin_nontemporal_load((const f32x4*)(src + i * 256 + lane * 4)); }
            }
#pragma unroll
            for (int r = 0; r < 4; ++r) {
                const int row = rowa + r * NW;
                if (row < MP) {
                    float ss = 0.f;
#pragma unroll
                    for (int i = 0; i < 4; ++i) {
                        const f32x4 x = v[r][i];
                        ss += x[0] * x[0] + x[1] * x[1] + x[2] * x[2] + x[3] * x[3];
                        u32x2 o; o.x = cvt_pk_bf16(x[0], x[1]); o.y = cvt_pk_bf16(x[2], x[3]);
                        *(u32x2*)(xb + (size_t)row * DM + i * 256 + lane * 4) = o;
                    }
                    ss = wave_sum(ss);
                    if (lane == 0) rstd1[row] = rsqrtf(ss * (1.0f / DM) + EPS);
                }
            }
        }
    }
    prep_weights(P, lds, 0, 16 * 44, blockIdx.x, gridDim.x);
    if (blockIdx.x == 0) {
        float* lb = (float*)(P.ws + WS_LB);
        const float a = P.rec_lb[tid], b = P.rec_lb[512 + tid];
        lb[tid] = 1.0f / (1.0f + expf(b - a));
    }
}

__device__ __forceinline__ void attn_prompt_item(const Params& P, unsigned char* lds, int item) {
    const int tid = threadIdx.x, w = __builtin_amdgcn_readfirstlane(tid >> 6), lane = tid & 63, fr = lane & 15, fq = lane >> 4;
    const int hkv = item & 1, nb = (item >> 1) & 63, b = item >> 7;
    bf16_t* Ks = (bf16_t*)lds;
    bf16_t* Vt = (bf16_t*)(lds + 36864);
    const bf16_t* proj = (const bf16_t*)(P.ws + WS_PROJ);
    bf16_t* mix = (bf16_t*)(P.ws + WS_MIX);
    const int h = hkv * 4 + (w >> 1);
    const bf16_t* qbase = proj + ((size_t)b * SEQ + nb * 128 + (w & 1) * 64 + fr) * INW + h * 64 + fq * 8;
    bf16x8 nq0 = *(const bf16x8*)qbase, nq1 = *(const bf16x8*)(qbase + 32);
    __syncthreads();
    {
        u32x4 kvs[4], vvs[4];
#pragma unroll
        for (int u = 0; u < 4; ++u) {
            const int c = tid + u * 512, r = c >> 3, ch = c & 7;
            kvs[u] = (u32x4){0u, 0u, 0u, 0u}; vvs[u] = (u32x4){0u, 0u, 0u, 0u};
            if (nb > 0 || r >= 128) {
                const size_t row = (size_t)b * SEQ + (size_t)((nb - 1) * 128 + r);
                const bf16_t* pr = proj + row * INW + 512 + hkv * 64 + ch * 8;
                kvs[u] = *(const u32x4*)pr; vvs[u] = *(const u32x4*)(pr + 128);
            }
        }
#pragma unroll
        for (int u = 0; u < 4; ++u) {
            const int c = tid + u * 512, r = c >> 3, ch = c & 7;
            const u32x4 kv = kvs[u], vv = vvs[u];
            *(u32x4*)(Ks + r * 72 + ch * 8) = kv;
#pragma unroll
            for (int i = 0; i < 8; ++i) Vt[(ch * 8 + i) * 264 + r] = (bf16_t)(vv[i >> 1] >> ((i & 1) * 16));
            if (nb == 63 && r >= 128) {
                const size_t o = ((size_t)(b * 128 + (r - 128)) * 2 + hkv) * 64 + ch * 8;
                float* ok = P.out + OUT_KP + o; float* ov = P.out + OUT_VP + o;
                *(f32x4*)ok = (f32x4){lo_bf(kv[0]), hi_bf(kv[0]), lo_bf(kv[1]), hi_bf(kv[1])}; *(f32x4*)(ok + 4) = (f32x4){lo_bf(kv[2]), hi_bf(kv[2]), lo_bf(kv[3]), hi_bf(kv[3])};
                *(f32x4*)ov = (f32x4){lo_bf(vv[0]), hi_bf(vv[0]), lo_bf(vv[1]), hi_bf(vv[1])}; *(f32x4*)(ov + 4) = (f32x4){lo_bf(vv[2]), hi_bf(vv[2]), lo_bf(vv[3]), hi_bf(vv[3])};
            }
        }
    }
    __syncthreads();
    const float sink2 = P.sinks[h] * 1.4426950408889634f;
    for (int it = 0; it < 4; ++it) {
        const int qi0 = (w & 1) * 64 + it * 16, kt0 = qi0 >> 4;
        const bf16x8 bq0 = nq0, bq1 = nq1;
        if (it < 3) { const bf16_t* qp = qbase + (size_t)(it + 1) * 16 * INW; nq0 = *(const bf16x8*)qp; nq1 = *(const bf16x8*)(qp + 32); }
        f32x4 s[9];
#pragma unroll
        for (int j = 0; j < 9; ++j) {
            const bf16_t* kp = Ks + ((kt0 + j) * 16 + fr) * 72 + fq * 8;
            f32x4 a = {0.f, 0.f, 0.f, 0.f};
            a = MFMA16(*(const bf16x8*)kp, bq0, a);
            a = MFMA16(*(const bf16x8*)(kp + 32), bq1, a);
            s[j] = a;
        }
        float m = sink2;
        if (nb > 0) {
#pragma unroll
            for (int e = 0; e < 4; ++e) {
                s[0][e] = (fq * 4 + e > fr) ? s[0][e] : -1e30f;
                s[8][e] = (fq * 4 + e <= fr) ? s[8][e] : -1e30f;
            }
        } else {
            const int qi = qi0 + fr;
#pragma unroll
            for (int j = 0; j < 9; ++j)
#pragma unroll
                for (int e = 0; e < 4; ++e) {
                    const int ki = (kt0 + j) * 16 + fq * 4 + e;
                    const bool valid = (ki > qi) && (ki <= qi + 128) && (ki >= 128);
                    s[j][e] = valid ? s[j][e] : -1e30f;
                }
        }
#pragma unroll
        for (int j = 0; j < 9; ++j)
#pragma unroll
            for (int e = 0; e < 4; ++e) m = fmaxf(m, s[j][e]);
        m = xmax_rows(m);
        float sum = 0.f;
#pragma unroll
        for (int j = 0; j < 9; ++j)
#pragma unroll
            for (int e = 0; e < 4; ++e) { const float p = __builtin_amdgcn_exp2f(s[j][e] - m); s[j][e] = p; sum += p; }
        sum = xsum_rows(sum);
        const float inv = 1.0f / (sum + __builtin_amdgcn_exp2f(sink2 - m));
        f32x4 o[4];
#pragma unroll
        for (int dt = 0; dt < 4; ++dt) o[dt] = (f32x4){0.f, 0.f, 0.f, 0.f};
#pragma unroll
        for (int kk = 0; kk < 5; ++kk) {
            const int j0 = 2 * kk, j1 = 2 * kk + 1, j1c = j1 < 9 ? j1 : 8;
            u32x4 pa;
            pa.x = cvt_pk_bf16(s[j0][0], s[j0][1]); pa.y = cvt_pk_bf16(s[j0][2], s[j0][3]);
            if (j1 < 9) { pa.z = cvt_pk_bf16(s[j1c][0], s[j1c][1]); pa.w = cvt_pk_bf16(s[j1c][2], s[j1c][3]); } else { pa.z = 0u; pa.w = 0u; }
            bf16x8 aop; __builtin_memcpy(&aop, &pa, 16);
#pragma unroll
            for (int dt = 0; dt < 4; ++dt) {
                const bf16_t* vp = Vt + (dt * 16 + fr) * 264 + fq * 4;
                u32x2 v0 = *(const u32x2*)(vp + (kt0 + j0) * 16), v1 = *(const u32x2*)(vp + (kt0 + j1c) * 16);
                u32x4 vb; vb.x = v0.x; vb.y = v0.y; vb.z = v1.x; vb.w = v1.y;
                bf16x8 bop; __builtin_memcpy(&bop, &vb, 16);
                o[dt] = MFMA16(bop, aop, o[dt]);
            }
        }
#pragma unroll
        for (int dt = 0; dt < 4; ++dt) {
            u32x2 ow; ow.x = cvt_pk_bf16(o[dt][0] * inv, o[dt][1] * inv); ow.y = cvt_pk_bf16(o[dt][2] * inv, o[dt][3] * inv);
            *(u32x2*)(mix + ((size_t)b * SEQ + nb * 128 + qi0 + fr) * DM + h * 64 + dt * 16 + fq * 4) = ow;
        }
    }
}

__device__ __forceinline__ void dec_attn_item(const Params& P, unsigned char* lds, int item) {
    const int tid = threadIdx.x, w = __builtin_amdgcn_readfirstlane(tid >> 6), lane = tid & 63;
    const int hkv = item & 1, b = item >> 1;
    float* Kl = (float*)lds;
    float* Vl = (float*)(lds + 33280);
    float* Pb = (float*)(lds + 66048);
    float* Qs = (float*)(lds + 66048 + 2048);
    const bf16_t* pr = (const bf16_t*)(P.ws + WS_PROJ) + (size_t)(TP + b) * INW;
    bf16_t* mix = (bf16_t*)(P.ws + WS_MIX);
    const float* ck = P.ck + (size_t)b * 16384 + hkv * 64; const float* cv = P.cv + (size_t)b * 16384 + hkv * 64;
    float* ok = P.out + OUT_KS + (size_t)b * 16384 + hkv * 64; float* ov = P.out + OUT_VS + (size_t)b * 16384 + hkv * 64;
    __syncthreads();
    {
        float kr[16], vr[16];
#pragma unroll
        for (int u = 0; u < 16; ++u) {
            const int idx = tid + u * 512, r = idx >> 6, c = idx & 63;
            if (r < 127) { kr[u] = ck[(r + 1) * 128 + c]; vr[u] = cv[(r + 1) * 128 + c]; } else { kr[u] = bf2f(pr[512 + hkv * 64 + c]); vr[u] = bf2f(pr[640 + hkv * 64 + c]); }
        }
#pragma unroll
        for (int u = 0; u < 16; ++u) {
            const int idx = tid + u * 512, r = idx >> 6, c = idx & 63;
            Kl[r * 65 + c] = kr[u]; Vl[r * 64 + c] = vr[u]; ok[r * 128 + c] = kr[u]; ov[r * 128 + c] = vr[u];
        }
    }
    const int h = hkv * 4 + (w & 3);
    if (w < 4) Qs[w * 64 + lane] = bf2f(pr[h * 64 + lane]);
    __syncthreads();
    float sum = 1.f;
    if (w < 4) {
        const float sink = P.sinks[h] * 1.4426950408889634f;
        float s0 = 0.f, s1 = 0.f;
#pragma unroll 8
        for (int d = 0; d < 64; ++d) { const float q = Qs[w * 64 + d]; s0 += q * Kl[lane * 65 + d]; s1 += q * Kl[(lane + 64) * 65 + d]; }
        const float m = fmaxf(sink, wave_max(fmaxf(s0, s1)));
        const float p0 = __builtin_amdgcn_exp2f(s0 - m), p1 = __builtin_amdgcn_exp2f(s1 - m);
        sum = wave_sum(p0 + p1) + __builtin_amdgcn_exp2f(sink - m);
        Pb[w * 128 + lane] = p0; Pb[w * 128 + 64 + lane] = p1;
    }
    __syncthreads();
    if (w < 4) {
        float o = 0.f;
#pragma unroll 8
        for (int key = 0; key < 128; ++key) o += Pb[w * 128 + key] * Vl[key * 64 + lane];
        mix[(size_t)(TP + b) * DM + h * 64 + lane] = f2bf(o / sum);
    }
}

__device__ __forceinline__ void dec_hgrn_item(const Params& P, unsigned char* lds, int item) {
    const int tid = threadIdx.x, w = __builtin_amdgcn_readfirstlane(tid >> 6), lane = tid & 63;
    const int h = item & 3, b = item >> 2;
    float* red = (float*)lds;
    float* ssb = (float*)(lds + 8192);
    const bf16_t* pr = (const bf16_t*)(P.ws + WS_PROJ) + (size_t)(TP + b) * INW;
    bf16_t* mix = (bf16_t*)(P.ws + WS_MIX);
    __syncthreads();
    const int v4 = tid & 31, kg = tid >> 5;
    f32x4 iv;
#pragma unroll
    for (int j = 0; j < 4; ++j) iv[j] = bf2f(pr[1792 + h * 128 + v4 * 4 + j]);
    const float* S0 = P.st + (size_t)(b * 4 + h) * 16384; float* So = P.out + OUT_SS + (size_t)(b * 4 + h) * 16384;
    f32x4 oacc = {0.f, 0.f, 0.f, 0.f};
    f32x4 sv[8]; float fv[8], qv[8];
#pragma unroll
    for (int kk = 0; kk < 8; ++kk) {
        const int dk = kg * 8 + kk;
        sv[kk] = *(const f32x4*)(S0 + dk * 128 + v4 * 4);
        fv[kk] = bf2f(pr[1280 + h * 128 + dk]); qv[kk] = bf2f(pr[768 + h * 128 + dk]);
    }
#pragma unroll
    for (int kk = 0; kk < 8; ++kk) {
        const int dk = kg * 8 + kk;
        const float f = __expf(fv[kk]), kq = 1.0f - f;
        const f32x4 sn = sv[kk] * f + iv * kq;
        *(f32x4*)(So + dk * 128 + v4 * 4) = sn;
        oacc += sn * qv[kk];
    }
    *(f32x4*)(red + kg * 128 + v4 * 4) = oacc;
    __syncthreads();
    float o = 0.f;
    if (tid < 128) {
#pragma unroll
        for (int g = 0; g < 16; ++g) o += red[g * 128 + tid];
        const float part = wave_sum(o * o);
        if (lane == 0) ssb[w] = part;
    }
    __syncthreads();
    if (tid < 128) {
        const float r = rsqrtf((ssb[0] + ssb[1]) * (1.0f / 128.0f) + EPS);
        const float g = bf2f(pr[2304 + h * 128 + tid]);
        mix[(size_t)(TP + b) * DM + 512 + h * 128 + tid] = f2bf(o * r * P.rec_norm[h * 128 + tid] * g);
    }
}

template <bool OUT>
__device__ __forceinline__ void hgrn_item(const Params& P, unsigned char* lds, int item) {
    const int tid = threadIdx.x, w = __builtin_amdgcn_readfirstlane(tid >> 6), lane = tid & 63, fr = lane & 15, fq = lane >> 4;
    const int sc = item & 31, s = item >> 5, h = s & 3, b = s >> 2;
    bf16_t* Qs = (bf16_t*)(lds);
    bf16_t* Qp = (bf16_t*)(lds + 8704);
    bf16_t* Kp = (bf16_t*)(lds + 17408);
    bf16_t* Kt = (bf16_t*)(lds + 26112);
    bf16_t* It = (bf16_t*)(lds + 36352);
    bf16_t* Am = (bf16_t*)(lds + 46592);
    float* dl = (float*)(lds + 49152);
    float* tot = (float*)(lds + 49664);
    float* Ob = (float*)(lds + 53760);
    const bf16_t* proj = (const bf16_t*)(P.ws + WS_PROJ);
    bf16_t* mix = (bf16_t*)(P.ws + WS_MIX);
    float* HU = (float*)(P.ws + WS_HU) + (size_t)item * 16384;
    float* HD = (float*)(P.ws + WS_HD) + (size_t)item * 128;
    __syncthreads();
    f32x4 S[8];
#pragma unroll
    for (int m = 0; m < 8; ++m)
#pragma unroll
        for (int e = 0; e < 4; ++e) S[m][e] = 0.f;
    if (OUT) {
#pragma unroll
        for (int m = 0; m < 8; ++m) S[m] = *(const f32x4*)(HU + ((m * 8 + w) * 64 + lane) * 4);
    }
    const int cp = tid & 63, tg = w, c0 = 2 * cp;
    float dtot0 = 0.f, dtot1 = 0.f;
    const float rn0 = OUT ? P.rec_norm[h * 128 + c0] : 0.f, rn1 = OUT ? P.rec_norm[h * 128 + c0 + 1] : 0.f;
    unsigned nlw[4], nqw[4], niw[4], ngw[4];
    {
        const size_t row0 = (size_t)b * SEQ + sc * 256;
#pragma unroll
        for (int tt = 0; tt < 4; ++tt) {
            const bf16_t* rp = proj + (row0 + tg * 4 + tt) * INW + h * 128 + c0;
            nlw[tt] = *(const unsigned*)(rp + 1280); niw[tt] = *(const unsigned*)(rp + 1792);
            if (OUT) { nqw[tt] = *(const unsigned*)(rp + 768); ngw[tt] = *(const unsigned*)(rp + 2304); }
        }
    }
    for (int sub = 0; sub < 8; ++sub) {
        const size_t row0 = (size_t)b * SEQ + sc * 256 + sub * 32;
        float l0[4], l1[4], q0[4], q1[4]; unsigned iw[4], gw[4];
#pragma unroll
        for (int tt = 0; tt < 4; ++tt) {
            l0[tt] = lo_bf(nlw[tt]) * 1.4426950408889634f; l1[tt] = hi_bf(nlw[tt]) * 1.4426950408889634f; iw[tt] = niw[tt];
            if (OUT) { q0[tt] = lo_bf(nqw[tt]); q1[tt] = hi_bf(nqw[tt]); gw[tt] = ngw[tt]; }
        }
        if (sub < 7) {
#pragma unroll
            for (int tt = 0; tt < 4; ++tt) {
                const bf16_t* rp = proj + (row0 + 32 + tg * 4 + tt) * INW + h * 128 + c0;
                nlw[tt] = *(const unsigned*)(rp + 1280); niw[tt] = *(const unsigned*)(rp + 1792);
                if (OUT) { nqw[tt] = *(const unsigned*)(rp + 768); ngw[tt] = *(const unsigned*)(rp + 2304); }
            }
        }
        float c0s[4], c1s[4];
        c0s[0] = l0[0]; c1s[0] = l1[0];
#pragma unroll
        for (int tt = 1; tt < 4; ++tt) { c0s[tt] = c0s[tt - 1] + l0[tt]; c1s[tt] = c1s[tt - 1] + l1[tt]; }
        tot[tg * 128 + c0] = c0s[3]; tot[tg * 128 + c0 + 1] = c1s[3];
        __syncthreads();
        float base0 = 0.f, base1 = 0.f, ref0 = 0.f, ref1 = 0.f, last0 = 0.f, last1 = 0.f;
#pragma unroll
        for (int g = 0; g < 8; ++g) {
            const float t0 = tot[g * 128 + c0], t1 = tot[g * 128 + c0 + 1];
            if (g < tg) { base0 += t0; base1 += t1; }
            if (g < 4) { ref0 += t0; ref1 += t1; }
            last0 += t0; last1 += t1;
        }
        float kt0[4], kt1[4];
#pragma unroll
        for (int tt = 0; tt < 4; ++tt) {
            const int t = tg * 4 + tt;
            const float b0 = base0 + c0s[tt], b1 = base1 + c1s[tt];
            const float k0 = 1.0f - __builtin_amdgcn_exp2f(l0[tt]), k1 = 1.0f - __builtin_amdgcn_exp2f(l1[tt]);
            kt0[tt] = k0 * __builtin_amdgcn_exp2f(last0 - b0); kt1[tt] = k1 * __builtin_amdgcn_exp2f(last1 - b1);
            if (OUT) {
                *(unsigned*)(Qs + t * 136 + c0) = cvt_pk_bf16(q0[tt] * __builtin_amdgcn_exp2f(b0), q1[tt] * __builtin_amdgcn_exp2f(b1));
                const float e0 = fminf(fmaxf(b0 - ref0, -115.f), 115.f), e1 = fminf(fmaxf(b1 - ref1, -115.f), 115.f);
                *(unsigned*)(Qp + t * 136 + c0) = cvt_pk_bf16(q0[tt] * __builtin_amdgcn_exp2f(e0), q1[tt] * __builtin_amdgcn_exp2f(e1));
                *(unsigned*)(Kp + t * 136 + c0) = cvt_pk_bf16(k0 * __builtin_amdgcn_exp2f(-e0), k1 * __builtin_amdgcn_exp2f(-e1));
            }
        }
        {
            u32x2 kw0, kw1, iw0, iw1;
            kw0.x = cvt_pk_bf16(kt0[0], kt0[1]); kw0.y = cvt_pk_bf16(kt0[2], kt0[3]); kw1.x = cvt_pk_bf16(kt1[0], kt1[1]); kw1.y = cvt_pk_bf16(kt1[2], kt1[3]);
            iw0.x = (iw[0] & 0xFFFFu) | (iw[1] << 16); iw0.y = (iw[2] & 0xFFFFu) | (iw[3] << 16);
            iw1.x = (iw[0] >> 16) | (iw[1] & 0xFFFF0000u); iw1.y = (iw[2] >> 16) | (iw[3] & 0xFFFF0000u);
            *(u32x2*)(Kt + c0 * 40 + tg * 4) = kw0; *(u32x2*)(Kt + (c0 + 1) * 40 + tg * 4) = kw1;
            *(u32x2*)(It + c0 * 40 + tg * 4) = iw0; *(u32x2*)(It + (c0 + 1) * 40 + tg * 4) = iw1;
        }
        if (tg == 0) { dl[c0] = __builtin_amdgcn_exp2f(last0); dl[c0 + 1] = __builtin_amdgcn_exp2f(last1); dtot0 += last0; dtot1 += last1; }
        __syncthreads();
        f32x4 o[2];
        if (OUT) {
            o[0] = (f32x4){0.f, 0.f, 0.f, 0.f}; o[1] = (f32x4){0.f, 0.f, 0.f, 0.f};
#pragma unroll
            for (int kk = 0; kk < 4; ++kk) {
                const int m0 = 2 * kk, m1 = 2 * kk + 1;
                u32x4 sb; sb.x = cvt_pk_bf16(S[m0][0], S[m0][1]); sb.y = cvt_pk_bf16(S[m0][2], S[m0][3]); sb.z = cvt_pk_bf16(S[m1][0], S[m1][1]); sb.w = cvt_pk_bf16(S[m1][2], S[m1][3]);
                bf16x8 bop; __builtin_memcpy(&bop, &sb, 16);
#pragma unroll
                for (int mt = 0; mt < 2; ++mt) {
                    const bf16_t* ap = Qs + (mt * 16 + fr) * 136 + fq * 4;
                    const u32x2 a0 = *(const u32x2*)(ap + m0 * 16), a1 = *(const u32x2*)(ap + m1 * 16);
                    u32x4 av; av.x = a0.x; av.y = a0.y; av.z = a1.x; av.w = a1.y;
                    bf16x8 aop; __builtin_memcpy(&aop, &av, 16);
                    o[mt] = MFMA16(aop, bop, o[mt]);
                }
            }
            if (w < 3) {
                const int mt = w > 0 ? 1 : 0, nt = w > 1 ? 1 : 0;
                f32x4 a = {0.f, 0.f, 0.f, 0.f};
#pragma unroll
                for (int ks = 0; ks < 4; ++ks) {
                    const bf16x8 aop = *(const bf16x8*)(Qp + (mt * 16 + fr) * 136 + ks * 32 + fq * 8);
                    const bf16x8 bop = *(const bf16x8*)(Kp + (nt * 16 + fr) * 136 + ks * 32 + fq * 8);
                    a = MFMA16(aop, bop, a);
                }
#pragma unroll
                for (int e = 0; e < 4; ++e) {
                    const int t = mt * 16 + fq * 4 + e, sx = nt * 16 + fr;
                    Am[t * 40 + sx] = (sx <= t) ? f2bf(a[e]) : (bf16_t)0;
                }
            } else if (w == 3) {
#pragma unroll
                for (int e = 0; e < 4; ++e) Am[(fq * 4 + e) * 40 + 16 + fr] = (bf16_t)0;
            }
            __syncthreads();
        }
        const bf16x8 bi = *(const bf16x8*)(It + (w * 16 + fr) * 40 + fq * 8);
        if (OUT) {
#pragma unroll
            for (int mt = 0; mt < 2; ++mt) {
                const bf16x8 aop = *(const bf16x8*)(Am + (mt * 16 + fr) * 40 + fq * 8);
                o[mt] = MFMA16(aop, bi, o[mt]);
            }
        }
#pragma unroll
        for (int m = 0; m < 8; ++m) {
            const f32x4 dv = *(const f32x4*)(dl + m * 16 + fq * 4);
            S[m] = S[m] * dv;
            const bf16x8 aop = *(const bf16x8*)(Kt + (m * 16 + fr) * 40 + fq * 8);
            S[m] = MFMA16(aop, bi, S[m]);
        }
        if (OUT) {
#pragma unroll
            for (int mt = 0; mt < 2; ++mt)
#pragma unroll
                for (int e = 0; e < 4; ++e) Ob[(mt * 16 + fq * 4 + e) * 132 + w * 16 + fr] = o[mt][e];
            __syncthreads();
#pragma unroll
            for (int tt = 0; tt < 4; ++tt) {
                const int t = w * 4 + tt;
                const float v0 = Ob[t * 132 + 2 * lane], v1 = Ob[t * 132 + 2 * lane + 1];
                const float ssq = wave_sum(v0 * v0 + v1 * v1);
                const float r = rsqrtf(ssq * (1.0f / 128.0f) + EPS);
                *(unsigned*)(mix + (row0 + t) * DM + 512 + h * 128 + 2 * lane) = cvt_pk_bf16(v0 * r * rn0 * lo_bf(gw[tt]), v1 * r * rn1 * hi_bf(gw[tt]));
            }
        }
    }
    if (!OUT) {
#pragma unroll
        for (int m = 0; m < 8; ++m)
#pragma unroll
            for (int e = 0; e < 1; ++e) *(f32x4*)(HU + ((m * 8 + w) * 64 + lane) * 4) = S[m];
        if (tg == 0) { HD[c0] = __builtin_amdgcn_exp2f(dtot0); HD[c0 + 1] = __builtin_amdgcn_exp2f(dtot1); }
    }
}

__device__ __forceinline__ void hgrn_state_item(const Params& P, unsigned char* lds, int item) {
    const int tid = threadIdx.x, w = __builtin_amdgcn_readfirstlane(tid >> 6), lane = tid & 63, fr = lane & 15, fq = lane >> 4;
    const int sc = item & 31, s = item >> 5, h = s & 3, b = s >> 2;
    bf16_t* Kt = (bf16_t*)(lds);
    bf16_t* It = (bf16_t*)(lds + 34816);
    float* dl = (float*)(lds + 69632);
    float* tot = (float*)(lds + 70144);
    const bf16_t* proj = (const bf16_t*)(P.ws + WS_PROJ);
    float* HU = (float*)(P.ws + WS_HU) + (size_t)item * 16384;
    float* HD = (float*)(P.ws + WS_HD) + (size_t)item * 128;
    const int c0 = 2 * lane, tg = w;
    f32x4 S[8];
#pragma unroll
    for (int m = 0; m < 8; ++m) S[m] = (f32x4){0.f, 0.f, 0.f, 0.f};
    float dtot0 = 0.f, dtot1 = 0.f;
    __syncthreads();
    for (int step = 0; step < 2; ++step) {
        const size_t row0 = (size_t)b * SEQ + sc * 256 + step * 128 + tg * 16;
        unsigned lw[16], iw[16];
#pragma unroll
        for (int tt = 0; tt < 16; ++tt) {
            const bf16_t* rp = proj + (row0 + tt) * INW + h * 128 + c0;
            lw[tt] = *(const unsigned*)(rp + 1280); iw[tt] = *(const unsigned*)(rp + 1792);
        }
        float c0s[16], c1s[16];
        float la[16], lb2[16];
#pragma unroll
        for (int tt = 0; tt < 16; ++tt) { la[tt] = lo_bf(lw[tt]) * 1.4426950408889634f; lb2[tt] = hi_bf(lw[tt]) * 1.4426950408889634f; }
        c0s[0] = la[0]; c1s[0] = lb2[0];
#pragma unroll
        for (int tt = 1; tt < 16; ++tt) { c0s[tt] = c0s[tt - 1] + la[tt]; c1s[tt] = c1s[tt - 1] + lb2[tt]; }
        tot[tg * 128 + c0] = c0s[15]; tot[tg * 128 + c0 + 1] = c1s[15];
        __syncthreads();
        float base0 = 0.f, base1 = 0.f, last0 = 0.f, last1 = 0.f;
#pragma unroll
        for (int g = 0; g < 8; ++g) {
            const float t0 = tot[g * 128 + c0], t1 = tot[g * 128 + c0 + 1];
            if (g < tg) { base0 += t0; base1 += t1; }
            last0 += t0; last1 += t1;
        }
        unsigned kw0[8], kw1[8], iw0[8], iw1[8];
#pragma unroll
        for (int t2 = 0; t2 < 8; ++t2) {
            float ka[2], kb[2];
#pragma unroll
            for (int u = 0; u < 2; ++u) {
                const int tt = 2 * t2 + u;
                const float b0 = base0 + c0s[tt], b1 = base1 + c1s[tt];
                ka[u] = (1.0f - __builtin_amdgcn_exp2f(la[tt])) * __builtin_amdgcn_exp2f(last0 - b0);
                kb[u] = (1.0f - __builtin_amdgcn_exp2f(lb2[tt])) * __builtin_amdgcn_exp2f(last1 - b1);
            }
            kw0[t2] = cvt_pk_bf16(ka[0], ka[1]); kw1[t2] = cvt_pk_bf16(kb[0], kb[1]);
            iw0[t2] = (iw[2 * t2] & 0xFFFFu) | (iw[2 * t2 + 1] << 16);
            iw1[t2] = (iw[2 * t2] >> 16) | (iw[2 * t2 + 1] & 0xFFFF0000u);
        }
#pragma unroll
        for (int q = 0; q < 2; ++q) {
            u32x4 a, bq, c, d;
            a.x = kw0[4 * q]; a.y = kw0[4 * q + 1]; a.z = kw0[4 * q + 2]; a.w = kw0[4 * q + 3];
            bq.x = kw1[4 * q]; bq.y = kw1[4 * q + 1]; bq.z = kw1[4 * q + 2]; bq.w = kw1[4 * q + 3];
            c.x = iw0[4 * q]; c.y = iw0[4 * q + 1]; c.z = iw0[4 * q + 2]; c.w = iw0[4 * q + 3];
            d.x = iw1[4 * q]; d.y = iw1[4 * q + 1]; d.z = iw1[4 * q + 2]; d.w = iw1[4 * q + 3];
            *(u32x4*)(Kt + c0 * 136 + tg * 16 + q * 8) = a; *(u32x4*)(Kt + (c0 + 1) * 136 + tg * 16 + q * 8) = bq;
            *(u32x4*)(It + c0 * 136 + tg * 16 + q * 8) = c; *(u32x4*)(It + (c0 + 1) * 136 + tg * 16 + q * 8) = d;
        }
        if (tg == 0) { dl[c0] = __builtin_amdgcn_exp2f(last0); dl[c0 + 1] = __builtin_amdgcn_exp2f(last1); dtot0 += last0; dtot1 += last1; }
        __syncthreads();
        bf16x8 bi[4];
#pragma unroll
        for (int ks = 0; ks < 4; ++ks) bi[ks] = *(const bf16x8*)(It + (w * 16 + fr) * 136 + ks * 32 + fq * 8);
#pragma unroll
        for (int m = 0; m < 8; ++m) {
            const f32x4 dv = *(const f32x4*)(dl + m * 16 + fq * 4);
            S[m] = S[m] * dv;
#pragma unroll
            for (int ks = 0; ks < 4; ++ks) {
                const bf16x8 aop = *(const bf16x8*)(Kt + (m * 16 + fr) * 136 + ks * 32 + fq * 8);
                S[m] = MFMA16(aop, bi[ks], S[m]);
            }
        }
    }
#pragma unroll
    for (int m = 0; m < 8; ++m)
#pragma unroll
        for (int e = 0; e < 1; ++e) *(f32x4*)(HU + ((m * 8 + w) * 64 + lane) * 4) = S[m];
    if (tg == 0) { HD[c0] = __builtin_amdgcn_exp2f(dtot0); HD[c0 + 1] = __builtin_amdgcn_exp2f(dtot1); }
}

__device__ __forceinline__ void phase_scan(const Params& P) {
    float* HU = (float*)(P.ws + WS_HU); const float* HD = (const float*)(P.ws + WS_HD);
    for (int e4 = blockIdx.x * 512 + threadIdx.x; e4 < 16 * 4096; e4 += gridDim.x * 512) {
        const int s = e4 >> 12, q = e4 & 4095;
        const int dk0 = (q >> 9) * 16 + ((q >> 4) & 3) * 4, dv = ((q >> 6) & 7) * 16 + (q & 15);
        f32x4 carry = {0.f, 0.f, 0.f, 0.f};
#pragma unroll
        for (int c8 = 0; c8 < 4; ++c8) {
            f32x4 u[8], d[8];
#pragma unroll
            for (int k = 0; k < 8; ++k) { const size_t it = (size_t)s * 32 + c8 * 8 + k; u[k] = *(const f32x4*)(HU + it * 16384 + q * 4); d[k] = *(const f32x4*)(HD + it * 128 + dk0); }
#pragma unroll
            for (int k = 0; k < 8; ++k) {
                const size_t it = (size_t)s * 32 + c8 * 8 + k;
                *(f32x4*)(HU + it * 16384 + q * 4) = carry;
                carry = d[k] * carry + u[k];
            }
        }
#pragma unroll
        for (int e = 0; e < 4; ++e) P.out[OUT_SP + (size_t)s * 16384 + (dk0 + e) * 128 + dv] = carry[e];
    }
}

__global__ void __launch_bounds__(512, 2) mk_fwd(Params P, int ph_lo, int ph_hi) {
    extern __shared__ __attribute__((aligned(16))) unsigned char shm[];
    cg::grid_group grid = cg::this_grid();
    const int tid = threadIdx.x, w = __builtin_amdgcn_readfirstlane(tid >> 6), lane = tid & 63;
#define IN_PH(p) (ph_lo <= (p) && (p) < ph_hi)
#define PH_LOOP(p) for (int rep = 0; rep < ((PROBE_DUP == (p)) ? 2 : 1); ++rep)
    volatile LAS unsigned* xst = (volatile LAS unsigned*)((LAS unsigned char*)shm + 131072);
    if (tid == 0) { xst[0] = 0u; xst[1] = 0u; }
    __syncthreads();
    (void)xcd_barrier_post((unsigned*)(P.ws + WS_BAR), xst);
#define XBAR() xcd_barrier((unsigned*)(P.ws + WS_BAR), (volatile LAS unsigned*)((LAS unsigned char*)shm + 131072))
#define PH_SYNC if (rep) XBAR()
#define SEAM(p) do { if (ph_lo <= (p) && (p) + 1 < ph_hi) XBAR(); } while (0)
    if (ph_hi > NPHASE + 1) grid.sync();
    if (PROBE_DUP == 100) { for (int r = 0; r < 10; ++r) XBAR(); }
    if (IN_PH(0)) PH_LOOP(0) { PH_SYNC; phase_prep(P, shm); }
    SEAM(0);
    if (IN_PH(1)) PH_LOOP(1) { PH_SYNC;
        pg8::Gemm g{(const bf16_t*)(P.ws + WS_XB), (const bf16_t*)(P.ws + WS_WIN), MP, INW, DM};
        pg8::StaticOrder S; S.init(MP, INW, DM, gridDim.x, blockIdx.x, 0);
        EpiIn E{(bf16_t*)(P.ws + WS_PROJ), (const float*)(P.ws + WS_RSTD1), (const float*)(P.ws + WS_LB)};
        pg8::gemm_phase<EpiIn>((LAS unsigned char*)shm, g, S, E);
        {
            const int G = gridDim.x, nfull = (MP / 256 * (INW / 256)) % G;
            const int total = 16 * 44 + 16 * 16 + 2 * 16 * 44 + 44 * 16;
            if (nfull == 0) prep_weights(P, shm, 16 * 44, total, blockIdx.x, G);
            else if ((int)blockIdx.x >= nfull) prep_weights(P, shm, 16 * 44, total, blockIdx.x - nfull, G - nfull);
        }
    }
    SEAM(1);
    if (IN_PH(2)) PH_LOOP(2) { PH_SYNC;
        for (int i = blockIdx.x; i < 512; i += gridDim.x) hgrn_state_item(P, shm, i);
        for (int i = blockIdx.x; i < 1280; i += gridDim.x) {
            if (i < 512) attn_prompt_item(P, shm, i);
            else if (i < 768) dec_attn_item(P, shm, i - 512);
            else dec_hgrn_item(P, shm, i - 768);
        }
    }
    SEAM(2);
    if (IN_PH(3)) phase_scan(P);
    SEAM(3);
    if (IN_PH(4)) PH_LOOP(4) { PH_SYNC;
        for (int i = blockIdx.x; i < 512; i += gridDim.x) hgrn_item<true>(P, shm, i);
    }
    SEAM(4);
    if (IN_PH(5)) PH_LOOP(5) { PH_SYNC;
        pg8::Gemm g{(const bf16_t*)(P.ws + WS_MIX), (const bf16_t*)(P.ws + WS_WOUT), MP, DM, DM};
        pg8::StaticOrder S; S.init(TP, DM, DM, gridDim.x, blockIdx.x, rep ? 0 : 4 * (DM / 256));
        EpiSq E{(bf16_t*)(P.ws + WS_MIXO), (float*)(P.ws + WS_SS2), (float*)(P.ws + WS_S2)};
        pg8::gemm_phase<EpiSq>((LAS unsigned char*)shm, g, S, E);
    }
    SEAM(5);
    if (IN_PH(6)) PH_LOOP(6) { PH_SYNC;
        bf16_t* x1b = (bf16_t*)(P.ws + WS_XB); float* rstd3 = (float*)(P.ws + WS_RSTD3);
        const bf16_t* mixo = (const bf16_t*)(P.ws + WS_MIXO); const float* ss2 = (const float*)(P.ws + WS_SS2);
        const int NW = gridDim.x * 8;
        for (int rb = blockIdx.x * 8 + w; rb < NS; rb += NW) {
            const int row = TP + rb;
            const float* sp = (const float*)(P.ws + WS_S2) + (size_t)rb * DM;
            f32x4 v[4]; float ssm = 0.f;
#pragma unroll
            for (int i = 0; i < 4; ++i) {
                v[i] = *(const f32x4*)(sp + i * 256 + lane * 4);
#pragma unroll
                for (int k = 1; k < 4; ++k) v[i] += *(const f32x4*)(sp + (size_t)k * (NS * DM) + i * 256 + lane * 4);
                ssm += v[i][0] * v[i][0] + v[i][1] * v[i][1] + v[i][2] * v[i][2] + v[i][3] * v[i][3];
            }
            const float r2 = rsqrtf(wave_sum(ssm) * (1.0f / DM) + EPS);
            float ss = 0.f;
#pragma unroll
            for (int i = 0; i < 4; ++i) {
                const u32x2 xw = *(const u32x2*)(x1b + (size_t)row * DM + i * 256 + lane * 4);
                const f32x4 gv = *(const f32x4*)(P.g2 + i * 256 + lane * 4);
                const float a0 = lo_bf(xw.x) + v[i][0] * r2 * gv[0], a1 = hi_bf(xw.x) + v[i][1] * r2 * gv[1], a2 = lo_bf(xw.y) + v[i][2] * r2 * gv[2], a3 = hi_bf(xw.y) + v[i][3] * r2 * gv[3];
                ss += a0 * a0 + a1 * a1 + a2 * a2 + a3 * a3;
                u32x2 o; o.x = cvt_pk_bf16(a0, a1); o.y = cvt_pk_bf16(a2, a3);
                *(u32x2*)(x1b + (size_t)row * DM + i * 256 + lane * 4) = o;
            }
            ss = wave_sum(ss);
            if (lane == 0) rstd3[row] = rsqrtf(ss * (1.0f / DM) + EPS);
        }
        for (int rowa = blockIdx.x * 8 + w; rowa < TP; rowa += 4 * NW) {
            u32x2 xw[4][4], mw[4][4]; float sv[4];
#pragma unroll
            for (int r = 0; r < 4; ++r) {
                const int row = min(rowa + r * NW, TP - 1);
                sv[r] = lane < 16 ? ss2[(size_t)row * 16 + lane] : 0.f;
#pragma unroll
                for (int i = 0; i < 4; ++i) { xw[r][i] = __builtin_nontemporal_load((const u32x2*)(x1b + (size_t)row * DM + i * 256 + lane * 4)); mw[r][i] = *(const u32x2*)(mixo + (size_t)row * DM + i * 256 + lane * 4); }
            }
#pragma unroll
            for (int r = 0; r < 4; ++r) {
                const int row = rowa + r * NW;
                const float r2 = rsqrtf(wave_sum(sv[r]) * (1.0f / DM) + EPS);
                float ss = 0.f;
                u32x2 o[4];
#pragma unroll
                for (int i = 0; i < 4; ++i) {
                    const f32x4 gv = *(const f32x4*)(P.g2 + i * 256 + lane * 4);
                    const float a0 = lo_bf(xw[r][i].x) + lo_bf(mw[r][i].x) * r2 * gv[0], a1 = hi_bf(xw[r][i].x) + hi_bf(mw[r][i].x) * r2 * gv[1];
                    const float a2 = lo_bf(xw[r][i].y) + lo_bf(mw[r][i].y) * r2 * gv[2], a3 = hi_bf(xw[r][i].y) + hi_bf(mw[r][i].y) * r2 * gv[3];
                    ss += a0 * a0 + a1 * a1 + a2 * a2 + a3 * a3;
                    o[i].x = cvt_pk_bf16(a0, a1); o[i].y = cvt_pk_bf16(a2, a3);
                }
                ss = wave_sum(ss);
                if (row < TP) {
#pragma unroll
                    for (int i = 0; i < 4; ++i) *(u32x2*)(x1b + (size_t)row * DM + i * 256 + lane * 4) = o[i];
                    if (lane == 0) rstd3[row] = rsqrtf(ss * (1.0f / DM) + EPS);
                }
            }
        }
    }
    SEAM(6);
    if (IN_PH(7)) PH_LOOP(7) { PH_SYNC;
        pg8::Gemm g{(const bf16_t*)(P.ws + WS_XB), (const bf16_t*)(P.ws + WS_WGU), MP, 2 * DFF, DM};
        pg8::StaticOrder S; S.init(TP, 2 * DFF, DM, gridDim.x, blockIdx.x, rep ? 0 : 22 * (DM / 256));
        EpiGU E{(bf16_t*)(P.ws + WS_PROJ), (const float*)(P.ws + WS_RSTD3), (float*)(P.ws + WS_S3)};
        pg8::gemm_phase<EpiGU>((LAS unsigned char*)shm, g, S, E);
    }
    SEAM(7);
    if (IN_PH(8)) PH_LOOP(8) { PH_SYNC;
        pg8::Gemm g{(const bf16_t*)(P.ws + WS_PROJ), (const bf16_t*)(P.ws + WS_WDN), MP, DM, DFF};
        pg8::StaticOrder S; S.init(TP, DM, DFF, gridDim.x, blockIdx.x, rep ? 0 : 4 * (DFF / 256));
        for (int i = 0;; ++i) {
            const long L = (long)i * gridDim.x + blockIdx.x;
            if (L >= 512 + S.nextra) break;
            if (L < 512) continue;
            const int ks = (int)((L - 512) / 4);
            const float* s3 = (const float*)(P.ws + WS_S3); const float* rstd3 = (const float*)(P.ws + WS_RSTD3);
            bf16_t* actp = (bf16_t*)(P.ws + WS_PROJ);
#pragma unroll 2
            for (int e = tid; e < 128 * 64; e += 512) {
                const int row = e >> 6, j = (e & 63) * 4, f = ks * 256 + j;
                const float rs = rstd3[TP + row];
                const float* gp = s3 + (size_t)row * (2 * DFF) + (f >> 7) * 256 + (f & 127);
                f32x4 g = *(const f32x4*)gp, u = *(const f32x4*)(gp + 128);
#pragma unroll
                for (int k = 1; k < 4; ++k) { const float* gk = gp + (size_t)k * (NS * 2 * DFF); g += *(const f32x4*)gk; u += *(const f32x4*)(gk + 128); }
                g *= rs; u *= rs;
                u32x2 o; o.x = cvt_pk_bf16(silu_f(g[0]) * u[0], silu_f(g[1]) * u[1]); o.y = cvt_pk_bf16(silu_f(g[2]) * u[2], silu_f(g[3]) * u[3]);
                *(u32x2*)(actp + (size_t)(TP + row) * DFF + f) = o;
            }
            asm volatile("s_waitcnt vmcnt(0)" ::: "memory");
            __syncthreads();
        }
        EpiSq E{(bf16_t*)(P.ws + WS_MIX), (float*)(P.ws + WS_SS4), (float*)(P.ws + WS_S4)};
        pg8::gemm_phase<EpiSq>((LAS unsigned char*)shm, g, S, E);
    }
    SEAM(8);
    if (IN_PH(9)) PH_LOOP(9) { PH_SYNC;
        const bf16_t* x1b = (const bf16_t*)(P.ws + WS_XB); const bf16_t* ffo = (const bf16_t*)(P.ws + WS_MIX); const float* ss4 = (const float*)(P.ws + WS_SS4);
        const int NW = gridDim.x * 8;
        for (int rb = blockIdx.x * 8 + w; rb < NS; rb += NW) {
            const float* sp = (const float*)(P.ws + WS_S4) + (size_t)rb * DM;
            f32x4 v[4]; float ssm = 0.f;
#pragma unroll
            for (int i = 0; i < 4; ++i) {
                v[i] = *(const f32x4*)(sp + i * 256 + lane * 4);
#pragma unroll
                for (int k = 1; k < 11; ++k) v[i] += *(const f32x4*)(sp + (size_t)k * (NS * DM) + i * 256 + lane * 4);
                ssm += v[i][0] * v[i][0] + v[i][1] * v[i][1] + v[i][2] * v[i][2] + v[i][3] * v[i][3];
            }
            const float r4 = rsqrtf(wave_sum(ssm) * (1.0f / DM) + EPS);
            float* dst = P.out + OUT_YS + (size_t)rb * DM;
#pragma unroll
            for (int i = 0; i < 4; ++i) {
                const u32x2 xw = *(const u32x2*)(x1b + (size_t)(TP + rb) * DM + i * 256 + lane * 4);
                const f32x4 gv = *(const f32x4*)(P.g4 + i * 256 + lane * 4);
                f32x4 y;
                y[0] = lo_bf(xw.x) + v[i][0] * r4 * gv[0]; y[1] = hi_bf(xw.x) + v[i][1] * r4 * gv[1]; y[2] = lo_bf(xw.y) + v[i][2] * r4 * gv[2]; y[3] = hi_bf(xw.y) + v[i][3] * r4 * gv[3];
                *(f32x4*)(dst + i * 256 + lane * 4) = y;
            }
        }
        for (int rowa = blockIdx.x * 8 + w; rowa < TP; rowa += 4 * NW) {
            u32x2 xw[4][4], fw[4][4]; float sv[4];
#pragma unroll
            for (int r = 0; r < 4; ++r) {
                const int row = min(rowa + r * NW, TP - 1);
                sv[r] = lane < 16 ? ss4[(size_t)row * 16 + lane] : 0.f;
#pragma unroll
                for (int i = 0; i < 4; ++i) { xw[r][i] = *(const u32x2*)(x1b + (size_t)row * DM + i * 256 + lane * 4); fw[r][i] = *(const u32x2*)(ffo + (size_t)row * DM + i * 256 + lane * 4); }
            }
#pragma unroll
            for (int r = 0; r < 4; ++r) {
                const int row = rowa + r * NW;
                const float r4 = rsqrtf(wave_sum(sv[r]) * (1.0f / DM) + EPS);
                if (row < TP) {
                    float* dst = P.out + OUT_YP + (size_t)row * DM;
#pragma unroll
                    for (int i = 0; i < 4; ++i) {
                        const f32x4 gv = *(const f32x4*)(P.g4 + i * 256 + lane * 4);
                        f32x4 y;
                        y[0] = lo_bf(xw[r][i].x) + lo_bf(fw[r][i].x) * r4 * gv[0]; y[1] = hi_bf(xw[r][i].x) + hi_bf(fw[r][i].x) * r4 * gv[1];
                        y[2] = lo_bf(xw[r][i].y) + lo_bf(fw[r][i].y) * r4 * gv[2]; y[3] = hi_bf(xw[r][i].y) + hi_bf(fw[r][i].y) * r4 * gv[3];
                        __builtin_nontemporal_store(y, (f32x4*)(dst + i * 256 + lane * 4));
                    }
                }
            }
        }
    }
#undef IN_PH
#undef SEAM
}

extern "C" void kernel_launch(void* const* d_in, const int* in_sizes, int n_in, void* d_out, int out_size, void* d_ws, size_t ws_size, hipStream_t stream) {
    static int grid = 0;
    if (grid == 0) {
        if (n_in != 17 || ws_size < WS_END) { fprintf(stderr, "kernel_launch: unexpected inputs (n_in %d, ws %zu, need %zu)\n", n_in, ws_size, (size_t)WS_END); grid = -1; return; }
        int dev = 0, cus = 0, per_cu = 0;
        hipGetDevice(&dev);
        hipDeviceGetAttribute(&cus, hipDeviceAttributeMultiprocessorCount, dev);
        if (hipFuncSetAttribute((const void*)mk_fwd, hipFuncAttributeMaxDynamicSharedMemorySize, LDS_BYTES) != hipSuccess) { fprintf(stderr, "kernel_launch: hipFuncSetAttribute failed\n"); grid = -1; return; }
        if (hipOccupancyMaxActiveBlocksPerMultiprocessor(&per_cu, (const void*)mk_fwd, 512, LDS_BYTES) != hipSuccess || per_cu < 1) { fprintf(stderr, "kernel_launch: occupancy query failed (%d)\n", per_cu); grid = -1; return; }
        grid = cus * per_cu;
    }
    if (grid < 0) return;
    if (hipMemsetAsync((char*)d_ws + WS_BAR, 0, 3456 * 4, stream) != hipSuccess) { fprintf(stderr, "kernel_launch: memset of the barrier words failed\n"); return; }
    Params p{};
    p.xp = (const float*)d_in[0]; p.xs = (const float*)d_in[1]; p.ck = (const float*)d_in[2]; p.cv = (const float*)d_in[3]; p.st = (const float*)d_in[4];
    p.w_in = (const float*)d_in[5]; p.w_out = (const float*)d_in[6]; p.w_gate = (const float*)d_in[7]; p.w_up = (const float*)d_in[8]; p.w_down = (const float*)d_in[9];
    p.g1 = (const float*)d_in[10]; p.g2 = (const float*)d_in[11]; p.g3 = (const float*)d_in[12]; p.g4 = (const float*)d_in[13];
    p.sinks = (const float*)d_in[14]; p.rec_lb = (const float*)d_in[15]; p.rec_norm = (const float*)d_in[16];
    p.out = (float*)d_out; p.ws = (unsigned char*)d_ws;
#if N_LAUNCH_MODE == 1
    for (int ph = 0; ph < NPHASE; ++ph) hipLaunchKernelGGL(mk_fwd, dim3(grid), dim3(512), LDS_BYTES, stream, p, ph, ph + 1);
#else
    int lo = 0, hi = NPHASE;
    void* args[] = {&p, &lo, &hi};
    hipError_t e = hipLaunchCooperativeKernel((const void*)mk_fwd, dim3(grid), dim3(512), args, LDS_BYTES, stream);
    if (e != hipSuccess) fprintf(stderr, "cooperative launch failed: %s (grid %d)\n", hipGetErrorString(e), grid);
#endif
}
```
